# Optimizing an MI355X kernel written in HIP

```python
import math
import jax, jax.numpy as jnp
from jax import lax
import numpy as np

D_MODEL = 1024
BATCH = 8
SEQ = 2048
DEPTH = 1

GLA_HEADS = 4
GLA_DK = D_MODEL // 8
GLA_DV = D_MODEL // 4
GLA_GATE_RANK = 16
GLA_GATE_TAU = 16.0
GLA_CHUNK = 64
GDN_HEADS = 8
GDN_DK = D_MODEL // 8
GDN_DV = D_MODEL // 8
GDN_CONV = 5
GDN_CHUNK = 64
N_GROUPS = 4
EXPERTS_PER_GROUP = 8
N_EXPERTS = N_GROUPS * EXPERTS_PER_GROUP
TOP_K = 2
D_EXPERT = D_MODEL // 4
MOE_BLOCK = 128
EPS = 1e-6

GLA_QK = GLA_HEADS * GLA_DK
GLA_V = GLA_HEADS * GLA_DV
GDN_QK = GDN_HEADS * GDN_DK
GDN_V = GDN_HEADS * GDN_DV
IN_SPLITS = (
    GLA_QK, GLA_QK, GLA_V, GLA_V,
    GLA_GATE_RANK, GLA_GATE_RANK,
    GDN_QK, GDN_QK, GDN_V, GDN_V,
    4 * GDN_HEADS,
    D_MODEL, D_MODEL,
)
D_IN = sum(IN_SPLITS)

kernel_name = 'hybrid_gla_gdn_hmoe_encoder'


def rms_norm(x, w):
    xf = x.astype(jnp.float32)
    y = xf * lax.rsqrt(jnp.mean(xf * xf, axis=-1, keepdims=True) + EPS)
    return (y * w.astype(jnp.float32)).astype(x.dtype)


def l2_norm(t):
    return t * lax.rsqrt(jnp.sum(t * t, axis=-1, keepdims=True) + EPS)


def to_heads(t, n_heads):
    b, l, _ = t.shape
    return t.reshape(b, l, n_heads, -1).transpose(0, 2, 1, 3)


def from_heads(t):
    b, h, l, d = t.shape
    return t.transpose(0, 2, 1, 3).reshape(b, l, h * d)


def rev(t):
    return jnp.flip(t, axis=2)


def gla_chunked(q, k, v, log_a):
    b_, h_, l_, dk = q.shape
    dv = v.shape[-1]
    c = GLA_CHUNK
    n = l_ // c
    q, k, log_a = (t.reshape(b_, h_, n, c, dk) for t in (q, k, log_a))
    v = v.reshape(b_, h_, n, c, dv)
    cum = jnp.cumsum(log_a, axis=3)
    cum_last = cum[:, :, :, -1:, :]
    q_dec = q * jnp.exp(cum)
    k_inv = k * jnp.exp(-cum)
    causal = jnp.tril(jnp.ones((c, c), dtype=bool))
    scores = jnp.where(causal, jnp.einsum('bhntd,bhnsd->bhnts', q_dec, k_inv), 0.0)
    o_intra = jnp.einsum('bhnts,bhnsv->bhntv', scores, v)
    k_tail = k * jnp.exp(cum_last - cum)
    chunk_kv = jnp.einsum('bhnsd,bhnsv->bhndv', k_tail, v)
    chunk_decay = jnp.exp(cum_last[:, :, :, 0, :])

    def step(state, inp):
        kv, dec = inp
        return dec[..., None] * state + kv, state

    _, states = lax.scan(step, jnp.zeros((b_, h_, dk, dv), q.dtype),
                         (jnp.moveaxis(chunk_kv, 2, 0), jnp.moveaxis(chunk_decay, 2, 0)))
    states = jnp.moveaxis(states, 0, 2)
    o_inter = jnp.einsum('bhntd,bhndv->bhntv', q_dec, states)
    return (o_intra + o_inter).reshape(b_, h_, l_, dv)


def gdn_chunked(q, k, v, g, beta):
    b_, h_, l_, dk = q.shape
    dv = v.shape[-1]
    c = GDN_CHUNK
    n = l_ // c
    q, k = (t.reshape(b_, h_, n, c, dk) for t in (q, k))
    v = v.reshape(b_, h_, n, c, dv)
    g = jnp.cumsum(g.reshape(b_, h_, n, c), axis=-1)
    beta = beta.reshape(b_, h_, n, c)
    tri = jnp.tril(jnp.ones((c, c), dtype=bool))
    strict = jnp.tril(jnp.ones((c, c), dtype=bool), -1)
    diff = g[..., :, None] - g[..., None, :]
    decay = jnp.where(tri, jnp.exp(jnp.where(tri, diff, 0.0)), 0.0)
    k_beta = k * beta[..., None]
    v_beta = v * beta[..., None]
    lower = jnp.where(strict, jnp.einsum('bhntd,bhnsd->bhnts', k_beta, k) * decay, 0.0)
    unit_lower = lower + jnp.eye(c, dtype=q.dtype)
    u = lax.linalg.triangular_solve(unit_lower, v_beta, left_side=True, lower=True,
                                    unit_diagonal=True)
    w = lax.linalg.triangular_solve(unit_lower, k_beta * jnp.exp(g)[..., None],
                                    left_side=True, lower=True, unit_diagonal=True)
    attn = jnp.where(tri, jnp.einsum('bhntd,bhnsd->bhnts', q, k) * decay, 0.0)
    g_last = g[..., -1]
    k_tail = k * jnp.exp(g_last[..., None] - g)[..., None]
    q_dec = q * jnp.exp(g)[..., None]
    chunk_decay = jnp.exp(g_last)

    def step(state, inp):
        q_c, k_c, u_c, w_c, a_c, dec_c = inp
        v_new = u_c - jnp.einsum('bhtd,bhdv->bhtv', w_c, state)
        o = (jnp.einsum('bhtd,bhdv->bhtv', q_c, state)
             + jnp.einsum('bhts,bhsv->bhtv', a_c, v_new))
        state = dec_c[..., None, None] * state + jnp.einsum('bhsd,bhsv->bhdv', k_c, v_new)
        return state, o

    xs = tuple(jnp.moveaxis(t, 2, 0) for t in (q_dec, k_tail, u, w, attn, chunk_decay))
    _, o = lax.scan(step, jnp.zeros((b_, h_, dk, dv), q.dtype), xs)
    return jnp.moveaxis(o, 0, 2).reshape(b_, h_, l_, dv)


def centred_depthwise_conv(x, w):
    kw, ch = w.shape
    pad = kw // 2
    return lax.conv_general_dilated(
        x, w[:, None, :].astype(x.dtype), window_strides=(1,), padding=[(pad, pad)],
        dimension_numbers=('NWC', 'WIO', 'NWC'), feature_group_count=ch)


def token_mixer(h, w_in, gla_w2_f, gla_b_f, gla_w2_b, gla_b_b, gla_norm_w, conv_w,
                a_log_f, dt_bias_f, a_log_b, dt_bias_b, gdn_norm_w, w_out):
    f32 = jnp.float32
    points = [int(p) for p in np.cumsum(IN_SPLITS)[:-1]]
    proj = h @ w_in
    (gq, gk, gv, gr, glr_f, glr_b, dq, dk, dv, dz, dab, m_a, m_b) = jnp.split(proj, points, axis=-1)

    q = to_heads(gq.astype(f32), GLA_HEADS) * (GLA_DK ** -0.5)
    k = to_heads(gk.astype(f32), GLA_HEADS)
    v = to_heads(gv.astype(f32), GLA_HEADS)
    la_f = to_heads(jax.nn.log_sigmoid((glr_f @ gla_w2_f + gla_b_f).astype(f32)) / GLA_GATE_TAU, GLA_HEADS)
    la_b = to_heads(jax.nn.log_sigmoid((glr_b @ gla_w2_b + gla_b_b).astype(f32)) / GLA_GATE_TAU, GLA_HEADS)
    o = gla_chunked(q, k, v, la_f) + rev(gla_chunked(rev(q), rev(k), rev(v), rev(la_b)))
    o_a = from_heads(rms_norm(o, gla_norm_w)) * jax.nn.silu(gr.astype(f32))

    qkv = jax.nn.silu(centred_depthwise_conv(jnp.concatenate([dq, dk, dv], axis=-1), conv_w))
    cq, ck, cv = jnp.split(qkv.astype(f32), [GDN_QK, 2 * GDN_QK], axis=-1)
    q = l2_norm(to_heads(cq, GDN_HEADS)) * (GDN_DK ** -0.5)
    k = l2_norm(to_heads(ck, GDN_HEADS))
    v = to_heads(cv, GDN_HEADS)
    a_f, a_b, b_f, b_b = (t.transpose(0, 2, 1) for t in jnp.split(dab.astype(f32), 4, axis=-1))
    g_f = -jnp.exp(a_log_f.astype(f32))[None, :, None] * jax.nn.softplus(a_f + dt_bias_f.astype(f32)[None, :, None])
    g_b = -jnp.exp(a_log_b.astype(f32))[None, :, None] * jax.nn.softplus(a_b + dt_bias_b.astype(f32)[None, :, None])
    beta_f = jax.nn.sigmoid(b_f)
    beta_b = jax.nn.sigmoid(b_b)
    o = (gdn_chunked(q, k, v, g_f, beta_f)
         + rev(gdn_chunked(rev(q), rev(k), rev(v), rev(g_b), rev(beta_b))))
    o_b = from_heads(rms_norm(o, gdn_norm_w)) * jax.nn.silu(dz.astype(f32))

    mixed = jax.nn.sigmoid(m_a.astype(f32)) * o_a + jax.nn.sigmoid(m_b.astype(f32)) * o_b
    return mixed.astype(h.dtype) @ w_out


def hierarchical_moe(h, w_group, w_router, w_gate, w_up, w_down):
    f32 = jnp.float32
    b_, l_, d = h.shape
    n_tok = b_ * l_
    t = h.reshape(n_tok, d)
    group_logits = (t @ w_group).astype(f32)
    group_prob = jax.nn.softmax(group_logits, axis=-1)
    group_idx = jnp.argmax(group_logits, axis=-1).astype(jnp.int32)
    group_w = jnp.take_along_axis(group_prob, group_idx[:, None], axis=-1)
    exp_logits = (t @ w_router).astype(f32).reshape(n_tok, N_GROUPS, EXPERTS_PER_GROUP)
    exp_logits = jnp.take_along_axis(exp_logits, group_idx[:, None, None], axis=1)[:, 0]
    top_p, top_i = lax.top_k(jax.nn.softmax(exp_logits, axis=-1), TOP_K)
    weights = group_w * top_p / jnp.sum(top_p, axis=-1, keepdims=True)
    expert_id = group_idx[:, None] * EXPERTS_PER_GROUP + top_i.astype(jnp.int32)

    n_assign = n_tok * TOP_K
    flat_e = expert_id.reshape(n_assign)
    flat_tok = jnp.repeat(jnp.arange(n_tok, dtype=jnp.int32), TOP_K)
    flat_w = weights.reshape(n_assign)
    order = jnp.argsort(flat_e)
    sorted_e = flat_e[order]
    counts = jnp.bincount(flat_e, length=N_EXPERTS)
    padded = (counts + MOE_BLOCK - 1) // MOE_BLOCK * MOE_BLOCK
    start = jnp.cumsum(counts) - counts
    ends = jnp.cumsum(padded)
    pstart = ends - padded
    dest = pstart[sorted_e] + jnp.arange(n_assign, dtype=jnp.int32) - start[sorted_e]
    n_blocks = -(-(n_assign + N_EXPERTS * (MOE_BLOCK - 1)) // MOE_BLOCK)
    n_rows = n_blocks * MOE_BLOCK
    row_tok = jnp.full((n_rows,), n_tok, jnp.int32).at[dest].set(flat_tok[order])
    row_w = jnp.zeros((n_rows,), f32).at[dest].set(flat_w[order])
    block_expert = jnp.minimum(
        jnp.searchsorted(ends, jnp.arange(n_blocks, dtype=jnp.int32) * MOE_BLOCK, side='right'),
        N_EXPERTS - 1)
    t_pad = jnp.concatenate([t, jnp.zeros((1, d), t.dtype)], axis=0)
    xb = t_pad[row_tok].reshape(n_blocks, MOE_BLOCK, d)

    def expert_block(args):
        xs, e = args
        hid = jax.nn.silu(xs @ w_gate[e]) * (xs @ w_up[e])
        return hid @ w_down[e]

    yb = lax.map(expert_block, (xb, block_expert)).reshape(n_rows, d)
    out = jnp.zeros((n_tok + 1, d), f32).at[row_tok].add(yb.astype(f32) * row_w[:, None])[:n_tok]
    return out.astype(h.dtype).reshape(b_, l_, d)


def setup_inputs(seed: int = 0) -> dict:
    key = jax.random.key(seed)
    ks = jax.random.split(key, 24)
    f32 = jnp.float32
    nl = DEPTH

    def nrm(k, shape, fan_in):
        return jax.random.normal(k, shape, f32) * (fan_in ** -0.5)

    def gain(k, shape):
        return 1.0 + 0.02 * jax.random.normal(k, shape, f32)

    def dt_bias(k):
        dt = jnp.exp(jax.random.uniform(k, (nl, GDN_HEADS), f32, math.log(1e-3), math.log(1e-1)))
        return dt + jnp.log(-jnp.expm1(-dt))

    def a_log(k):
        return jnp.log(jax.random.uniform(k, (nl, GDN_HEADS), f32, 1.0, 16.0))

    return {
        'x': jax.random.normal(ks[0], (BATCH, SEQ, D_MODEL), f32),
        'norm1_w': gain(ks[1], (nl, D_MODEL)),
        'w_in': nrm(ks[2], (nl, D_MODEL, D_IN), D_MODEL),
        'gla_gate_w2_fwd': nrm(ks[3], (nl, GLA_GATE_RANK, GLA_QK), GLA_GATE_RANK),
        'gla_gate_b_fwd': 0.1 * jax.random.normal(ks[4], (nl, GLA_QK), f32),
        'gla_gate_w2_bwd': nrm(ks[5], (nl, GLA_GATE_RANK, GLA_QK), GLA_GATE_RANK),
        'gla_gate_b_bwd': 0.1 * jax.random.normal(ks[6], (nl, GLA_QK), f32),
        'gla_norm_w': gain(ks[7], (nl, GLA_DV)),
        'gdn_conv_w': nrm(ks[8], (nl, GDN_CONV, 2 * GDN_QK + GDN_V), GDN_CONV),
        'gdn_a_log_fwd': a_log(ks[9]),
        'gdn_dt_bias_fwd': dt_bias(ks[10]),
        'gdn_a_log_bwd': a_log(ks[11]),
        'gdn_dt_bias_bwd': dt_bias(ks[12]),
        'gdn_norm_w': gain(ks[13], (nl, GDN_DV)),
        'w_out': nrm(ks[14], (nl, D_MODEL, D_MODEL), D_MODEL),
        'norm2_w': gain(ks[15], (nl, D_MODEL)),
        'moe_w_group': nrm(ks[16], (nl, D_MODEL, N_GROUPS), D_MODEL),
        'moe_w_router': nrm(ks[17], (nl, D_MODEL, N_EXPERTS), D_MODEL),
        'moe_w_gate': nrm(ks[18], (nl, N_EXPERTS, D_MODEL, D_EXPERT), D_MODEL),
        'moe_w_up': nrm(ks[19], (nl, N_EXPERTS, D_MODEL, D_EXPERT), D_MODEL),
        'moe_w_down': nrm(ks[20], (nl, N_EXPERTS, D_EXPERT, D_MODEL), D_EXPERT),
        'norm_f_w': gain(ks[21], (D_MODEL,)),
    }


def reference(x, norm1_w, w_in, gla_gate_w2_fwd, gla_gate_b_fwd, gla_gate_w2_bwd, gla_gate_b_bwd,
              gla_norm_w, gdn_conv_w, gdn_a_log_fwd, gdn_dt_bias_fwd, gdn_a_log_bwd, gdn_dt_bias_bwd,
              gdn_norm_w, w_out, norm2_w, moe_w_group, moe_w_router, moe_w_gate, moe_w_up,
              moe_w_down, norm_f_w):
    for i in range(DEPTH):
        h = rms_norm(x, norm1_w[i])
        x = x + token_mixer(h, w_in[i], gla_gate_w2_fwd[i], gla_gate_b_fwd[i], gla_gate_w2_bwd[i],
                            gla_gate_b_bwd[i], gla_norm_w[i], gdn_conv_w[i], gdn_a_log_fwd[i],
                            gdn_dt_bias_fwd[i], gdn_a_log_bwd[i], gdn_dt_bias_bwd[i], gdn_norm_w[i],
                            w_out[i])
        h = rms_norm(x, norm2_w[i])
        x = x + hierarchical_moe(h, moe_w_group[i], moe_w_router[i], moe_w_gate[i], moe_w_up[i],
                                 moe_w_down[i])
    return rms_norm(x, norm_f_w)
```

```cpp
#include <hip/hip_runtime.h>
#include <hip/hip_cooperative_groups.h>
#include <cstdio>
#include <cstdint>
namespace cg = cooperative_groups;

#define LAS __attribute__((address_space(3)))
typedef unsigned short bf16_t;
typedef short bf16x8 __attribute__((ext_vector_type(8)));
typedef float f32x4 __attribute__((ext_vector_type(4)));
typedef float f32x2 __attribute__((ext_vector_type(2)));
typedef unsigned u32x4 __attribute__((ext_vector_type(4)));
typedef unsigned u32x2 __attribute__((ext_vector_type(2)));

constexpr int D = 1024, NB = 8, SEQ = 2048, NTOK = NB * SEQ, DIN = 9280;
constexpr int N1 = 5376;
constexpr int C_GQ = 0, C_GK = 512, C_GV = 1024, C_DQ = 2048, C_DK = 3072, C_DV = 4096, C_GLR = 5120, C_DAB = 5152, N1_USED = 5184;
constexpr int NEXP = 32, DEXP = 256, LISTCAP = 16384, HID_ROWS = 40960;
constexpr float EPS = 1e-6f;
constexpr int LDS_BYTES = 147456;
constexpr int NTHR = 512, NWAVES = 8;

constexpr size_t OFF_CTL = 0;
constexpr size_t OFF_PROJ = 65536;
constexpr size_t SZ_PROJ = (size_t)NTOK * N1 * 2;
constexpr size_t OFF_XN = OFF_PROJ + SZ_PROJ;
constexpr size_t OFF_WT1 = OFF_XN + (size_t)NTOK * D * 2;
constexpr size_t OFF_WT3 = OFF_WT1 + (size_t)N1 * D * 2;
constexpr size_t OFF_WTO = OFF_WT3 + (size_t)4096 * D * 2;
constexpr size_t OFF_END1 = OFF_WTO + (size_t)D * D * 2;
constexpr size_t OFF_X1 = OFF_PROJ;
constexpr size_t OFF_MIX = OFF_X1 + (size_t)NTOK * D * 4;
constexpr size_t OFF_WGU = OFF_MIX + (size_t)NTOK * D * 2;
constexpr size_t OFF_WD = OFF_WGU + (size_t)NEXP * 512 * D * 2;
constexpr size_t OFF_HID = OFF_WD + (size_t)NEXP * D * DEXP * 2;
constexpr size_t OFF_OVL_END = OFF_HID + (size_t)HID_ROWS * DEXP * 2;
static_assert(OFF_OVL_END <= OFF_XN, "overlay exceeds the projection region");
constexpr size_t OFF_YB = OFF_XN;
constexpr size_t OFF_LSLOT = OFF_YB + (size_t)2 * NTOK * D * 2;
constexpr size_t OFF_LW = OFF_LSLOT + (size_t)NEXP * LISTCAP * 4;
constexpr size_t WS_NEED = OFF_LW + (size_t)NEXP * LISTCAP * 4;
static_assert(OFF_LSLOT >= OFF_END1, "lists overlap live weights");

struct Params {
    const float* x; const float* norm1_w; const float* w_in; const float* gla_w2_f; const float* gla_b_f; const float* gla_w2_b; const float* gla_b_b;
    const float* gla_norm_w; const float* conv_w; const float* a_log_f; const float* dt_bias_f; const float* a_log_b; const float* dt_bias_b; const float* gdn_norm_w;
    const float* w_out; const float* norm2_w; const float* w_group; const float* w_router; const float* w_gate; const float* w_up; const float* w_down; const float* norm_f_w;
    float* out; unsigned char* ws;
    int ph_lo, ph_hi;
};

__device__ __forceinline__ unsigned f2bf(float f) { unsigned u = __float_as_uint(f); return (u + 0x7fffu + ((u >> 16) & 1u)) >> 16; }
__device__ __forceinline__ float bf2f(unsigned short b) { return __uint_as_float(((unsigned)b) << 16); }
__device__ __forceinline__ unsigned pk2(float lo, float hi) { return f2bf(lo) | (f2bf(hi) << 16); }
__device__ __forceinline__ float bflo(unsigned w) { return __uint_as_float(w << 16); }
__device__ __forceinline__ float bfhi(unsigned w) { return __uint_as_float(w & 0xffff0000u); }
__device__ __forceinline__ float wave_sum(float v) {
#pragma unroll
    for (int o = 1; o < 64; o <<= 1) v += __shfl_xor(v, o);
    return v;
}
__device__ __forceinline__ float sigmoid_f(float x) { return 1.f / (1.f + __expf(-x)); }
__device__ __forceinline__ float silu_f(float x) { return x / (1.f + __expf(-x)); }
#define LDS_WAIT() asm volatile("s_waitcnt lgkmcnt(0)" ::: "memory")

namespace pg8 {
constexpr int BM = 256, BK = 64, HALF = 128, HTB = HALF * BK * 2, STAGE_BYTES = 8 * HTB, NXCD = 8, WGM = 8;
__host__ __device__ __forceinline__ int lds_byte(int r, int c) { const int st = (r >> 4) * 2 + (c >> 5), rr = r & 15, cc = c & 31, ob = rr * 64 + cc * 2; return st * 1024 + (ob ^ (((ob >> 9) & 1) << 5)); }
__host__ __device__ __forceinline__ void stage_rc(int b, int& R, int& C) { const int st = b / 1024, sb = b % 1024, swz = sb ^ (((sb >> 9) & 1) << 5); R = (st >> 1) * 16 + swz / 64; C = (st & 1) * 32 + (swz % 64) / 2; }
__host__ __device__ __forceinline__ int perm32(int rho) { const int n = rho >> 4, i = rho & 15; return 8 * (i >> 2) + 4 * n + (i & 3); }
struct Unit { int pm, pn; };
struct Gemm { const bf16_t* A; const bf16_t* Bt; int M, N, K; };
struct StaticOrder {
    int nM, nN, nwg, G, c;
    __host__ __device__ void init(int M, int N, int G_, int c_) { nM = M / BM; nN = N / BM; nwg = nM * nN; G = G_; c = c_; }
    __host__ __device__ bool next(int i, Unit& u) const {
        const long L = (long)i * G + c; if (L >= nwg) return false;
        int wgid = (int)L; { const int q = nwg / NXCD, r = nwg % NXCD, xcd = wgid % NXCD, off = wgid / NXCD; wgid = (xcd < r ? xcd * (q + 1) : r * (q + 1) + (xcd - r) * q) + off; }
        const int nig = WGM * nN, gid = wgid / nig, fm = gid * WGM, gsz = (nM - fm) < WGM ? (nM - fm) : WGM;
        u.pm = fm + ((wgid % nig) % gsz); u.pn = (wgid % nig) / gsz; return true;
    }
    __device__ __forceinline__ void a_ready(const Unit&) const {}
    __device__ __forceinline__ void done(const Unit&) const {}
};
__device__ __forceinline__ unsigned cvt_pk_bf16(float lo, float hi) { unsigned r; asm volatile("v_cvt_pk_bf16_f32 %0, %1, %2" : "=v"(r) : "v"(lo), "v"(hi)); return r; }

struct EpiBf16 {
    static constexpr bool PERM = true;
    bf16_t* O; int ldc;
    __device__ __forceinline__ void operator()(const f32x4 (&acc)[2][2][4][2], const Unit& u, int wr, int wc, int fr, int fq) const {
        const int row0 = u.pm * BM + wr * 64 + fr, col0 = u.pn * BM + wc * 32 + 8 * fq;
#pragma unroll
        for (int ai = 0; ai < 2; ++ai)
#pragma unroll
            for (int m = 0; m < 4; ++m) { bf16_t* rowp = O + (size_t)(row0 + ai * HALF + m * 16) * ldc + col0;
#pragma unroll
                for (int bj = 0; bj < 2; ++bj) { const f32x4 v0 = acc[ai][bj][m][0], v1 = acc[ai][bj][m][1];
                    u32x4 w; w.x = cvt_pk_bf16(v0[0], v0[1]); w.y = cvt_pk_bf16(v0[2], v0[3]); w.z = cvt_pk_bf16(v1[0], v1[1]); w.w = cvt_pk_bf16(v1[2], v1[3]);
                    *(u32x4*)(rowp + bj * HALF) = w; } }
    }
};
struct EpiMix {
    static constexpr bool PERM = true;
    const bf16_t* ona; const bf16_t* onb; bf16_t* mixed;
    __device__ __forceinline__ void operator()(const f32x4 (&acc)[2][2][4][2], const Unit& u, int wr, int wc, int fr, int fq) const {
        const int row0 = u.pm * BM + wr * 64 + fr, mc0 = u.pn * 64 + wc * 16 + 4 * fq;
#pragma unroll
        for (int ai = 0; ai < 2; ++ai)
#pragma unroll
            for (int m = 0; m < 4; ++m) { const size_t off = (size_t)(row0 + ai * HALF + m * 16) * D + mc0;
                const u32x2 oa = *(const u32x2*)(ona + off), ob = *(const u32x2*)(onb + off);
                const float a4[4] = {bflo(oa.x), bfhi(oa.x), bflo(oa.y), bfhi(oa.y)}, b4[4] = {bflo(ob.x), bfhi(ob.x), bflo(ob.y), bfhi(ob.y)};
                float r[4];
#pragma unroll
                for (int i = 0; i < 4; ++i) r[i] = sigmoid_f(acc[ai][0][m][1][i]) * silu_f(acc[ai][0][m][0][i]) * a4[i] + sigmoid_f(acc[ai][1][m][1][i]) * silu_f(acc[ai][1][m][0][i]) * b4[i];
                u32x2 w; w.x = cvt_pk_bf16(r[0], r[1]); w.y = cvt_pk_bf16(r[2], r[3]);
                *(u32x2*)(mixed + off) = w; }
    }
};
struct EpiRes {
    static constexpr bool PERM = false;
    const float* base; float* C; int ldc;
    __device__ __forceinline__ void operator()(const f32x4 (&acc)[2][2][4][2], const Unit& u, int wr, int wc, int fr, int fq) const {
        const int row0 = u.pm * BM + wr * 64 + fr, col0 = u.pn * BM + wc * 32 + 4 * fq;
#pragma unroll
        for (int ai = 0; ai < 2; ++ai)
#pragma unroll
            for (int m = 0; m < 4; ++m) { const size_t off = (size_t)(row0 + ai * HALF + m * 16) * ldc + col0;
#pragma unroll
                for (int bj = 0; bj < 2; ++bj)
#pragma unroll
                    for (int n = 0; n < 2; ++n) { const f32x4 b = *(const f32x4*)(base + off + bj * HALF + n * 16); *(f32x4*)(C + off + bj * HALF + n * 16) = b + acc[ai][bj][m][n]; } }
    }
};

template <class Epi, class Sched>
__device__ __forceinline__ void gemm_phase(LAS unsigned char* lds, const Gemm g, const Sched& S, const Epi& E) {
    const int tid = threadIdx.x, wid = __builtin_amdgcn_readfirstlane(tid >> 6), lane = tid & 63, wr = wid >> 2, wc = wid & 3, fr = lane & 15, fq = lane >> 4;
    const int K = g.K, nt = K / BK;
    unsigned voffA[2], voffB[2];
#pragma unroll
    for (int i = 0; i < 2; ++i) { int R, C; stage_rc(tid * 16 + i * 8192, R, C); const int Rb = Epi::PERM ? ((R & ~31) + perm32(R & 31)) : R;
        voffA[i] = (unsigned)(R * K + C) * 2u; voffB[i] = (unsigned)(Rb * K + C) * 2u; }
    const size_t kstep = (size_t)(BK * 2);
    const size_t hstep = (size_t)HALF * K * 2;
    const size_t tstep = 2 * hstep;
    const unsigned ldsw = (unsigned)wid * 1024u;
    const int aoff = lds_byte(wr * 64 + fr, fq * 8), boff = lds_byte(wc * 32 + fr, fq * 8);
#define PG8_SA(b, h) (((b) * 2 + (h)) * HTB)
#define PG8_SB(b, h) ((4 + (b) * 2 + (h)) * HTB)
#define PG8_STAGE(bufoff, gbase, voff) do { _Pragma("unroll") for (int _i = 0; _i < 2; ++_i) \
        __builtin_amdgcn_global_load_lds((const unsigned*)((const char*)(gbase) + (voff)[_i]), (LAS unsigned*)(lds + (bufoff) + ldsw + _i * 8192), 16, 0, 0); } while (0)
#define PG8_LDA(dst, b, h) do { _Pragma("unroll") for (int m = 0; m < 4; ++m) _Pragma("unroll") for (int k = 0; k < 2; ++k) dst[m][k] = *(const LAS bf16x8*)(lds + PG8_SA(b, h) + aoff + m * 2048 + k * 1024); } while (0)
#define PG8_LDB(dst, b, h) do { _Pragma("unroll") for (int n = 0; n < 2; ++n) _Pragma("unroll") for (int k = 0; k < 2; ++k) dst[n][k] = *(const LAS bf16x8*)(lds + PG8_SB(b, h) + boff + n * 2048 + k * 1024); } while (0)
#define PG8_MMA(ai, bj, At, Bt) do { __builtin_amdgcn_s_setprio(1); _Pragma("unroll") for (int m = 0; m < 4; ++m) _Pragma("unroll") for (int n = 0; n < 2; ++n) _Pragma("unroll") for (int k = 0; k < 2; ++k) \
        acc[ai][bj][m][n] = __builtin_amdgcn_mfma_f32_16x16x32_bf16(Bt[n][k], At[m][k], acc[ai][bj][m][n], 0, 0, 0); __builtin_amdgcn_s_setprio(0); } while (0)
#define PG8_WAIT_V(n) asm volatile("s_waitcnt vmcnt(" #n ")" ::: "memory")
#define PG8_WAIT_L(n) asm volatile("s_waitcnt lgkmcnt(" #n ")" ::: "memory")
#define PG8_BAR __builtin_amdgcn_s_barrier()
#define PG8_SCHED __builtin_amdgcn_sched_barrier(0)
    Unit cur, nxt; int ui = 0;
    if (!S.next(0, cur)) return;
    f32x4 acc[2][2][4][2];
#pragma unroll
    for (int a = 0; a < 2; ++a)
#pragma unroll
        for (int b = 0; b < 2; ++b)
#pragma unroll
            for (int m = 0; m < 4; ++m)
#pragma unroll
                for (int n = 0; n < 2; ++n) acc[a][b][m][n] = (f32x4){0.f, 0.f, 0.f, 0.f};
    bf16x8 At[4][2], B0[2][2], B1[2][2];
    const char* cA = (const char*)g.A + (size_t)cur.pm * tstep; const char* cB = (const char*)g.Bt + (size_t)cur.pn * tstep;
    S.a_ready(cur);
    PG8_STAGE(PG8_SB(0, 0), cB, voffB); PG8_STAGE(PG8_SA(0, 0), cA, voffA); PG8_STAGE(PG8_SB(0, 1), cB + hstep, voffB); PG8_STAGE(PG8_SA(0, 1), cA + hstep, voffA);
    if (wr == 1) PG8_BAR;
    PG8_WAIT_V(4); PG8_BAR;
    PG8_STAGE(PG8_SB(1, 0), cB + kstep, voffB); PG8_STAGE(PG8_SA(1, 0), cA + kstep, voffA); PG8_STAGE(PG8_SB(1, 1), cB + hstep + kstep, voffB);
    PG8_WAIT_V(6); PG8_BAR;
    for (;;) {
        const bool has_next = S.next(ui + 1, nxt);
        const char* nA = has_next ? (const char*)g.A + (size_t)nxt.pm * tstep : cA; const char* nB = has_next ? (const char*)g.Bt + (size_t)nxt.pn * tstep : cB;
        for (int t = 0; t < nt; t += 2) {
            const bool last = (t == nt - 2);
            const char* a1 = cA + (size_t)(t + 1) * kstep;
            const char* a2 = last ? nA : cA + (size_t)(t + 2) * kstep; const char* b2 = last ? nB : cB + (size_t)(t + 2) * kstep;
            const char* a3 = a2 + kstep; const char* b3 = b2 + kstep;
            if (last && has_next) S.a_ready(nxt);
            PG8_LDB(B0, 0, 0); PG8_SCHED; PG8_LDA(At, 0, 0); PG8_STAGE(PG8_SA(1, 1), a1 + hstep, voffA);
            PG8_WAIT_L(8); PG8_BAR; PG8_WAIT_L(0); PG8_MMA(0, 0, At, B0); PG8_BAR; PG8_SCHED;
            PG8_LDB(B1, 0, 1); PG8_STAGE(PG8_SB(0, 0), b2, voffB);
            PG8_BAR; PG8_WAIT_L(0); PG8_MMA(0, 1, At, B1); PG8_BAR;
            PG8_LDA(At, 0, 1); PG8_STAGE(PG8_SA(0, 0), a2, voffA);
            PG8_BAR; PG8_WAIT_L(0); PG8_MMA(1, 0, At, B0); PG8_BAR; PG8_SCHED;
            PG8_STAGE(PG8_SB(0, 1), b2 + hstep, voffB);
            PG8_WAIT_V(6); PG8_BAR; PG8_MMA(1, 1, At, B1); PG8_BAR;
            PG8_LDB(B0, 1, 0); PG8_SCHED; PG8_LDA(At, 1, 0); PG8_STAGE(PG8_SA(0, 1), a2 + hstep, voffA);
            PG8_WAIT_L(8); PG8_BAR; PG8_WAIT_L(0); PG8_MMA(0, 0, At, B0); PG8_BAR; PG8_SCHED;
            PG8_LDB(B1, 1, 1); PG8_STAGE(PG8_SB(1, 0), b3, voffB);
            PG8_BAR; PG8_WAIT_L(0); PG8_MMA(0, 1, At, B1); PG8_BAR;
            PG8_LDA(At, 1, 1); PG8_STAGE(PG8_SA(1, 0), a3, voffA);
            PG8_BAR; PG8_WAIT_L(0); PG8_MMA(1, 0, At, B0); PG8_BAR; PG8_SCHED;
            PG8_STAGE(PG8_SB(1, 1), b3 + hstep, voffB);
            PG8_WAIT_V(6); PG8_BAR; PG8_MMA(1, 1, At, B1); PG8_BAR;
        }
        E(acc, cur, wr, wc, fr, fq); S.done(cur);
        if (!has_next) break;
#pragma unroll
        for (int a = 0; a < 2; ++a)
#pragma unroll
            for (int b = 0; b < 2; ++b)
#pragma unroll
                for (int m = 0; m < 4; ++m)
#pragma unroll
                    for (int n = 0; n < 2; ++n) acc[a][b][m][n] = (f32x4){0.f, 0.f, 0.f, 0.f};
        cur = nxt; cA = nA; cB = nB; ++ui;
    }
    PG8_WAIT_V(0);
    if (wr == 0) PG8_BAR;
    PG8_BAR;
#undef PG8_SA
#undef PG8_SB
#undef PG8_STAGE
#undef PG8_LDA
#undef PG8_LDB
#undef PG8_MMA
#undef PG8_WAIT_V
#undef PG8_WAIT_L
#undef PG8_BAR
#undef PG8_SCHED
}
}

template <class RowPtr>
__device__ __forceinline__ void transpose_item(const float* W, int ldw, int k0, int n0, const float* kscale, LAS float* scr, int lane, const RowPtr& rowptr) {
#pragma unroll 8
    for (int i = 0; i < 32; ++i) { const int kk = 2 * i + (lane >> 5); float v = W[(size_t)(k0 + kk) * ldw + n0 + (lane & 31)]; if (kscale) v *= kscale[k0 + kk]; scr[kk * 33 + (lane & 31)] = v; }
    LDS_WAIT();
    const int c = lane & 7;
#pragma unroll
    for (int j = 0; j < 4; ++j) { const int n = (lane >> 3) + 8 * j; const LAS float* s = scr + (8 * c) * 33 + n;
        u32x4 o; o.x = pk2(s[0 * 33], s[1 * 33]); o.y = pk2(s[2 * 33], s[3 * 33]); o.z = pk2(s[4 * 33], s[5 * 33]); o.w = pk2(s[6 * 33], s[7 * 33]);
        *(u32x4*)(rowptr(n0 + n) + k0 + 8 * c) = o; }
    LDS_WAIT();
}

struct WinRow {
    bf16_t* wt1; bf16_t* wt3;
    __device__ __forceinline__ bf16_t* operator()(int c) const {
        if (c < 2048) return wt1 + (size_t)c * D;
        if (c < 3072) { const int cc = c - 2048; return wt3 + (size_t)(256 * (cc >> 6) + 8 * ((cc & 63) >> 2) + (cc & 3)) * D; }
        if (c < 3104) return wt1 + (size_t)(C_GLR + (c - 3072)) * D;
        if (c < 6176) return wt1 + (size_t)(C_DQ + (c - 3104)) * D;
        if (c < 7200) { const int cc = c - 6176; return wt3 + (size_t)(256 * (cc >> 6) + 128 + 8 * ((cc & 63) >> 2) + (cc & 3)) * D; }
        if (c < 7232) return wt1 + (size_t)(C_DAB + (c - 7200)) * D;
        if (c < 8256) { const int cc = c - 7232; return wt3 + (size_t)(256 * (cc >> 6) + 8 * ((cc & 63) >> 2) + 4 + (cc & 3)) * D; }
        { const int cc = c - 8256; return wt3 + (size_t)(256 * (cc >> 6) + 128 + 8 * ((cc & 63) >> 2) + 4 + (cc & 3)) * D; }
    }
};
struct PlainRow { bf16_t* base; int K; __device__ __forceinline__ bf16_t* operator()(int c) const { return base + (size_t)c * K; } };
struct GuRow { bf16_t* base; int up; __device__ __forceinline__ bf16_t* operator()(int c) const { return base + (size_t)(8 * (c >> 2) + 4 * up + (c & 3)) * D; } };

__device__ __forceinline__ void p0_prologue(const Params& p, LAS unsigned char* lds) {
    const int tid = threadIdx.x, lane = tid & 63, wave = tid >> 6;
    const int gw = blockIdx.x * NWAVES + wave, NGW = gridDim.x * NWAVES;
    LAS float* scr = (LAS float*)(lds + wave * 8448);
    bf16_t* wt1 = (bf16_t*)(p.ws + OFF_WT1); bf16_t* wt3 = (bf16_t*)(p.ws + OFF_WT3); bf16_t* wto = (bf16_t*)(p.ws + OFF_WTO); bf16_t* xn = (bf16_t*)(p.ws + OFF_XN);
    const WinRow wr{wt1, wt3};
    constexpr int I_IN = 16 * (DIN / 32), I_OUT = 16 * (D / 32);
    for (int it = gw; it < I_IN + I_OUT; it += NGW) {
        if (it < I_IN) { const int kb = it / (DIN / 32), nb = it % (DIN / 32); transpose_item(p.w_in, DIN, kb * 64, nb * 32, p.norm1_w, scr, lane, wr); }
        else { const int r = it - I_IN, kb = r / (D / 32), nb = r % (D / 32); transpose_item(p.w_out, D, kb * 64, nb * 32, nullptr, scr, lane, PlainRow{wto, D}); }
    }
    { const int gt = blockIdx.x * NTHR + tid, NGT = gridDim.x * NTHR; u32x4* z = (u32x4*)(wt1 + (size_t)N1_USED * D); const int nz = (N1 - N1_USED) * D / 8;
      for (int i = gt; i < nz; i += NGT) z[i] = (u32x4){0u, 0u, 0u, 0u}; }
    for (int m = gw; m < NTOK; m += NGW) {
        const f32x4* xr = (const f32x4*)(p.x + (size_t)m * D) + lane;
        f32x4 v[4]; float s = 0.f;
#pragma unroll
        for (int j = 0; j < 4; ++j) { v[j] = xr[64 * j]; s += (v[j].x * v[j].x + v[j].y * v[j].y) + (v[j].z * v[j].z + v[j].w * v[j].w); }
        const float rstd = rsqrtf(wave_sum(s) * (1.f / D) + EPS);
        u32x2* o8 = (u32x2*)(xn + (size_t)m * D) + lane;
#pragma unroll
        for (int j = 0; j < 4; ++j) { u32x2 w; w.x = pk2(v[j].x * rstd, v[j].y * rstd); w.y = pk2(v[j].z * rstd, v[j].w * rstd); o8[64 * j] = w; }
    }
}

__device__ __forceinline__ float log_sigmoid_f(float z) { return fminf(z, 0.f) - log1pf(expf(-fabsf(z))); }
__device__ __forceinline__ float softplus_f(float z) { return z > 20.f ? z : log1pf(expf(z)); }

__device__ __forceinline__ void p2_gla_item(const Params& p, int b, int h, LAS float* sm) {
    const int tid = threadIdx.x, j = tid & 255, pp = tid >> 8, lane = tid & 63, wave = tid >> 6;
    LAS float* s_q = sm; LAS float* s_k = sm + 128; LAS float* s_a = sm + 256; LAS float* s_glr = sm + 384; LAS float* s_b = sm + 400; LAS float* s_w2 = sm + 528; LAS float* s_op = sm + 528 + 2048;
    const bf16_t* proj = (const bf16_t*)(p.ws + OFF_PROJ); bf16_t* og = (bf16_t*)p.out;
    for (int dir = 0; dir < 2; ++dir) {
        const float* w2 = dir ? p.gla_w2_b : p.gla_w2_f; const float* bb = dir ? p.gla_b_b : p.gla_b_f;
        __syncthreads();
        for (int i = tid; i < 2048; i += NTHR) { const int r = i >> 7, d = i & 127; s_w2[i] = w2[r * 512 + h * 128 + d]; }
        if (tid < 128) s_b[tid] = bb[h * 128 + tid];
        float S[64];
#pragma unroll
        for (int i = 0; i < 64; ++i) S[i] = 0.f;
        unsigned short nq = 0, nk = 0, ng = 0, nv = 0;
        { const bf16_t* rp = proj + (size_t)(b * SEQ + (dir ? SEQ - 1 : 0)) * N1;
          if (tid < 128) { nq = rp[C_GQ + h * 128 + tid]; nk = rp[C_GK + h * 128 + tid]; } else if (tid < 144) ng = rp[C_GLR + dir * 16 + tid - 128];
          nv = rp[C_GV + h * 256 + j]; }
        for (int step = 0; step < SEQ; ++step) {
            const int t = dir ? SEQ - 1 - step : step; const size_t row = (size_t)b * SEQ + t;
            if (tid < 128) { s_q[tid] = bf2f(nq) * 0.08838834764831845f; s_k[tid] = bf2f(nk); } else if (tid < 144) s_glr[tid - 128] = bf2f(ng);
            const float v = bf2f(nv);
            if (step + 1 < SEQ) { const bf16_t* rp = proj + (size_t)(b * SEQ + (dir ? t - 1 : t + 1)) * N1;
                if (tid < 128) { nq = rp[C_GQ + h * 128 + tid]; nk = rp[C_GK + h * 128 + tid]; } else if (tid < 144) ng = rp[C_GLR + dir * 16 + tid - 128];
                nv = rp[C_GV + h * 256 + j]; }
            __syncthreads();
            if (tid < 128) { float z = s_b[tid];
#pragma unroll
                for (int r = 0; r < 16; ++r) z += s_glr[r] * s_w2[r * 128 + tid];
                s_a[tid] = expf(log_sigmoid_f(z) * (1.f / 16.f)); }
            __syncthreads();
            float o = 0.f;
#pragma unroll
            for (int dd = 0; dd < 64; ++dd) { const int d = 64 * pp + dd; S[dd] = s_a[d] * S[dd] + s_k[d] * v; o += s_q[d] * S[dd]; }
            s_op[pp * 256 + j] = o;
            __syncthreads();
            if (pp == 0) { float ot = s_op[j] + s_op[256 + j]; bf16_t* op = og + row * D + h * 256 + j; if (dir) ot += bf2f(*op); *op = (bf16_t)f2bf(ot); }
        }
    }
    __threadfence(); __syncthreads();
    for (int r = wave; r < SEQ; r += NWAVES) {
        u32x2* op = (u32x2*)(og + ((size_t)b * SEQ + r) * D + h * 256) + lane; const u32x2 w = *op;
        const float v0 = bflo(w.x), v1 = bfhi(w.x), v2 = bflo(w.y), v3 = bfhi(w.y);
        const float rstd = rsqrtf(wave_sum((v0 * v0 + v1 * v1) + (v2 * v2 + v3 * v3)) * (1.f / 256.f) + EPS);
        const f32x4 g = *(const f32x4*)(p.gla_norm_w + lane * 4);
        u32x2 o; o.x = pk2(v0 * rstd * g.x, v1 * rstd * g.y); o.y = pk2(v2 * rstd * g.z, v3 * rstd * g.w); *op = o;
    }
}

__device__ __forceinline__ void p2_gdn_item(const Params& p, int b, int h, LAS float* sm) {
    const int tid = threadIdx.x, j = tid & 127, pp = tid >> 7, lane = tid & 63, wave = tid >> 6;
    LAS float* s_c = sm;
    LAS float* s_sc = sm + 384;
    LAS float* s_p1 = sm + 392;
    LAS float* s_p2 = sm + 392 + 512;
    const bf16_t* proj = (const bf16_t*)(p.ws + OFF_PROJ); bf16_t* og = (bf16_t*)p.out + (size_t)NTOK * D;
    float cw[5] = {0.f, 0.f, 0.f, 0.f, 0.f}; int col = 0;
    if (tid < 384) { const int ch = (tid >> 7) * 1024 + h * 128 + (tid & 127); col = C_DQ + ch;
#pragma unroll
        for (int jj = 0; jj < 5; ++jj) cw[jj] = p.conv_w[jj * 3072 + ch]; }
    for (int dir = 0; dir < 2; ++dir) {
        const float A = -expf(dir ? p.a_log_b[h] : p.a_log_f[h]), dtb = dir ? p.dt_bias_b[h] : p.dt_bias_f[h];
        float S[32];
#pragma unroll
        for (int i = 0; i < 32; ++i) S[i] = 0.f;
        unsigned short xw[5] = {0, 0, 0, 0, 0}; unsigned short na = 0, nbt = 0;
        { const int t = dir ? SEQ - 1 : 0;
          if (tid < 384) {
#pragma unroll
              for (int jj = 0; jj < 5; ++jj) { const int tt = t + jj - 2; xw[jj] = (tt >= 0 && tt < SEQ) ? proj[(size_t)(b * SEQ + tt) * N1 + col] : (unsigned short)0; } }
          else if (tid == 384) { const bf16_t* rp = proj + (size_t)(b * SEQ + t) * N1 + C_DAB; na = rp[dir * 8 + h]; nbt = rp[16 + dir * 8 + h]; } }
        __syncthreads();
        for (int step = 0; step < SEQ; ++step) {
            const int t = dir ? SEQ - 1 - step : step; const size_t row = (size_t)b * SEQ + t;
            if (tid < 384) { float a = 0.f;
#pragma unroll
                for (int jj = 0; jj < 5; ++jj) a += cw[jj] * bf2f(xw[jj]);
                s_c[tid] = silu_f(a); }
            else if (tid == 384) { const float g = A * softplus_f(bf2f(na) + dtb); s_sc[2] = expf(g); s_sc[3] = 1.f / (1.f + expf(-bf2f(nbt))); }
            if (step + 1 < SEQ) { const int tn = dir ? t - 1 : t + 1;
                if (tid < 384) {
#pragma unroll
                    for (int jj = 0; jj < 5; ++jj) { const int tt = tn + jj - 2; xw[jj] = (tt >= 0 && tt < SEQ) ? proj[(size_t)(b * SEQ + tt) * N1 + col] : (unsigned short)0; } }
                else if (tid == 384) { const bf16_t* rp = proj + (size_t)(b * SEQ + tn) * N1 + C_DAB; na = rp[dir * 8 + h]; nbt = rp[16 + dir * 8 + h]; } }
            __syncthreads();
            if (wave < 2) { const float a0 = s_c[wave * 128 + lane], a1 = s_c[wave * 128 + 64 + lane]; const float ss = wave_sum(a0 * a0 + a1 * a1);
                if (lane == 0) s_sc[wave] = rsqrtf(ss + EPS) * (wave == 0 ? 0.08838834764831845f : 1.f); }
            __syncthreads();
            const float rq = s_sc[0], rk = s_sc[1], alpha = s_sc[2], beta = s_sc[3];
            float pred = 0.f;
#pragma unroll
            for (int dd = 0; dd < 32; ++dd) { const int d = 32 * pp + dd; S[dd] *= alpha; pred += s_c[128 + d] * S[dd]; }
            s_p1[pp * 128 + j] = pred * rk;
            __syncthreads();
            const float predt = (s_p1[j] + s_p1[128 + j]) + (s_p1[256 + j] + s_p1[384 + j]);
            const float delta = beta * (s_c[256 + j] - predt) * rk;
            float o = 0.f;
#pragma unroll
            for (int dd = 0; dd < 32; ++dd) { const int d = 32 * pp + dd; S[dd] += s_c[128 + d] * delta; o += s_c[d] * S[dd]; }
            s_p2[pp * 128 + j] = o * rq;
            __syncthreads();
            if (pp == 0) { float ot = (s_p2[j] + s_p2[128 + j]) + (s_p2[256 + j] + s_p2[384 + j]); bf16_t* op = og + row * D + h * 128 + j; if (dir) ot += bf2f(*op); *op = (bf16_t)f2bf(ot); }
        }
    }
    __threadfence(); __syncthreads();
    for (int r = wave; r < SEQ; r += NWAVES) {
        unsigned* op = (unsigned*)(og + ((size_t)b * SEQ + r) * D + h * 128) + lane; const unsigned w = *op;
        const float v0 = bflo(w), v1 = bfhi(w);
        const float rstd = rsqrtf(wave_sum(v0 * v0 + v1 * v1) * (1.f / 128.f) + EPS);
        const f32x2 g = *(const f32x2*)(p.gdn_norm_w + lane * 2);
        *op = pk2(v0 * rstd * g.x, v1 * rstd * g.y);
    }
}

__device__ __forceinline__ void p2_scans(const Params& p, LAS unsigned char* lds) {
    LAS float* sm = (LAS float*)lds;
    for (int it = blockIdx.x; it < 96; it += gridDim.x) {
        __syncthreads();
        if (it < 32) p2_gla_item(p, it >> 2, it & 3, sm);
        else { const int r = it - 32; p2_gdn_item(p, r >> 3, r & 7, sm); }
    }
}

__device__ __forceinline__ void p5_router(const Params& p, LAS unsigned char* lds) {
    const int tid = threadIdx.x, lane = tid & 63, wave = __builtin_amdgcn_readfirstlane(tid >> 6);
    const int gw = blockIdx.x * NWAVES + wave, NGW = gridDim.x * NWAVES;
    { LAS float* scr = (LAS float*)(lds + wave * 8448);
      bf16_t* wgu = (bf16_t*)(p.ws + OFF_WGU); bf16_t* wd = (bf16_t*)(p.ws + OFF_WD);
      for (int it = gw; it < NEXP * 384; it += NGW) {
          const int e = it / 384, r = it % 384;
          if (r < 128) { const int kb = r >> 3, nb = r & 7; transpose_item(p.w_gate + (size_t)e * D * DEXP, DEXP, kb * 64, nb * 32, p.norm2_w, scr, lane, GuRow{wgu + (size_t)e * 512 * D, 0}); }
          else if (r < 256) { const int q = r - 128, kb = q >> 3, nb = q & 7; transpose_item(p.w_up + (size_t)e * D * DEXP, DEXP, kb * 64, nb * 32, p.norm2_w, scr, lane, GuRow{wgu + (size_t)e * 512 * D, 1}); }
          else { const int q = r - 256, kb = q >> 5, nb = q & 31; transpose_item(p.w_down + (size_t)e * DEXP * D, D, kb * 64, nb * 32, nullptr, scr, lane, PlainRow{wd + (size_t)e * D * DEXP, DEXP}); }
      } }
    __syncthreads();
    LAS float* part = (LAS float*)lds;
    LAS float* s_rstd = part + 8 * 64 * 37;
    const float* x1 = (const float*)(p.ws + OFF_X1); bf16_t* h2 = (bf16_t*)(p.ws + OFF_MIX);
    unsigned* cnt = (unsigned*)(p.ws + OFF_CTL); int* lslot = (int*)(p.ws + OFF_LSLOT); float* lw = (float*)(p.ws + OFF_LW);
    const float* __restrict__ nw2 = p.norm2_w; const float* __restrict__ wg = p.w_group; const float* __restrict__ wrt = p.w_router;
    for (int blk = blockIdx.x; blk < NTOK / 64; blk += gridDim.x) {
        const int tok = blk * 64 + lane;
        float acc[36]; float ss = 0.f;
#pragma unroll
        for (int i = 0; i < 36; ++i) acc[i] = 0.f;
        const float* xr = x1 + (size_t)tok * D + wave * 128;
#pragma unroll 1
        for (int kk = 0; kk < 128; kk += 4) {
            const f32x4 xv = *(const f32x4*)(xr + kk); const int k = wave * 128 + kk;
            ss += (xv.x * xv.x + xv.y * xv.y) + (xv.z * xv.z + xv.w * xv.w);
#pragma unroll
            for (int i = 0; i < 4; ++i) { const float xs = xv[i] * nw2[k + i];
#pragma unroll
                for (int jj = 0; jj < 4; ++jj) acc[jj] += xs * wg[(k + i) * 4 + jj];
#pragma unroll
                for (int jj = 0; jj < 32; ++jj) acc[4 + jj] += xs * wrt[(k + i) * 32 + jj]; }
        }
#pragma unroll
        for (int i = 0; i < 36; ++i) part[(wave * 64 + lane) * 37 + i] = acc[i];
        part[(wave * 64 + lane) * 37 + 36] = ss;
        __syncthreads();
        if (wave == 0) {
            float l[36]; float st = 0.f;
#pragma unroll
            for (int i = 0; i < 36; ++i) l[i] = 0.f;
#pragma unroll 1
            for (int w = 0; w < 8; ++w) {
#pragma unroll
                for (int i = 0; i < 36; ++i) l[i] += part[(w * 64 + lane) * 37 + i];
                st += part[(w * 64 + lane) * 37 + 36]; }
            const float rstd = rsqrtf(st * (1.f / D) + EPS);
            s_rstd[lane] = rstd;
#pragma unroll
            for (int i = 0; i < 36; ++i) l[i] *= rstd;
            int gi = 0; float gm = l[0];
#pragma unroll
            for (int i = 1; i < 4; ++i) if (l[i] > gm) { gm = l[i]; gi = i; }
            float gs = 0.f;
#pragma unroll
            for (int i = 0; i < 4; ++i) gs += expf(l[i] - gm);
            const float group_w = 1.f / gs;
            float el[8];
#pragma unroll
            for (int i = 0; i < 8; ++i) el[i] = gi == 0 ? l[4 + i] : gi == 1 ? l[12 + i] : gi == 2 ? l[20 + i] : l[28 + i];
            int i1 = 0; float m1 = el[0];
#pragma unroll
            for (int i = 1; i < 8; ++i) if (el[i] > m1) { m1 = el[i]; i1 = i; }
            int i2 = -1; float m2 = -3.0e38f;
#pragma unroll
            for (int i = 0; i < 8; ++i) if (i != i1 && el[i] > m2) { m2 = el[i]; i2 = i; }
            const float e2 = expf(m2 - m1);
            const float w1 = group_w / (1.f + e2), w2 = group_w * e2 / (1.f + e2);
            const int ea = gi * 8 + i1, eb = gi * 8 + i2;
            const unsigned pa = atomicAdd(&cnt[ea], 1u); lslot[ea * LISTCAP + pa] = tok * 2; lw[ea * LISTCAP + pa] = w1;
            const unsigned pb = atomicAdd(&cnt[eb], 1u); lslot[eb * LISTCAP + pb] = tok * 2 + 1; lw[eb * LISTCAP + pb] = w2;
        }
        __syncthreads();
#pragma unroll
        for (int r = 0; r < 8; ++r) {
            const int row = blk * 64 + wave * 8 + r; const float rs = s_rstd[wave * 8 + r];
            const f32x4* xq = (const f32x4*)(x1 + (size_t)row * D) + lane; u32x2* o8 = (u32x2*)(h2 + (size_t)row * D) + lane;
#pragma unroll
            for (int jj = 0; jj < 4; ++jj) { const f32x4 v = xq[64 * jj]; u32x2 w; w.x = pk2(v.x * rs, v.y * rs); w.y = pk2(v.z * rs, v.w * rs); o8[64 * jj] = w; }
        }
        __syncthreads();
    }
}

__device__ __forceinline__ void moe_tables(const Params& p, LAS int* tab, int per_rb) {
    const unsigned* cnt = (const unsigned*)(p.ws + OFF_CTL);
    if (threadIdx.x == 0) { int hr = 0, pre = 0;
        for (int e = 0; e < NEXP; ++e) { const int c = (int)cnt[e]; tab[e] = c; tab[32 + e] = hr; tab[64 + e] = pre; hr += ((c + 255) >> 8) << 8; pre += ((c + 63) >> 6) * per_rb; }
        tab[64 + 32] = pre; }
    __syncthreads();
}
__device__ __forceinline__ void p6_expert_up(const Params& p, LAS unsigned char* lds) {
    LAS int* tab = (LAS int*)lds; moe_tables(p, tab, 8);
    const int tid = threadIdx.x, lane = tid & 63, wave = tid >> 6, fr = lane & 15, fq = lane >> 4;
    const int gw = blockIdx.x * NWAVES + wave, NGW = gridDim.x * NWAVES, total = tab[96];
    const bf16_t* h2 = (const bf16_t*)(p.ws + OFF_MIX); const bf16_t* wgu = (const bf16_t*)(p.ws + OFF_WGU); bf16_t* hid = (bf16_t*)(p.ws + OFF_HID);
    const int* lslot = (const int*)(p.ws + OFF_LSLOT);
    for (int it = gw; it < total; it += NGW) {
        int e = 0;
#pragma unroll 1
        for (int q = 1; q < NEXP; ++q) if (it >= tab[64 + q]) e = q;
        const int r = it - tab[64 + e], rb = r >> 3, hb = r & 7, c = tab[e];
        const bf16_t* ap[4];
#pragma unroll
        for (int mi = 0; mi < 4; ++mi) { const int a = rb * 64 + 16 * mi + fr; const int tok = a < c ? (lslot[e * LISTCAP + a] >> 1) : 0; ap[mi] = h2 + (size_t)tok * D + 8 * fq; }
        const bf16_t* bp[2][2];
#pragma unroll
        for (int ni = 0; ni < 2; ++ni) { const int n = hb * 32 + 16 * ni + fr; const int prow = 8 * (n >> 2) + (n & 3); bp[0][ni] = wgu + ((size_t)e * 512 + prow) * D + 8 * fq; bp[1][ni] = bp[0][ni] + 4 * D; }
        f32x4 ag[4][2], au[4][2];
#pragma unroll
        for (int mi = 0; mi < 4; ++mi)
#pragma unroll
            for (int ni = 0; ni < 2; ++ni) { ag[mi][ni] = (f32x4){0.f, 0.f, 0.f, 0.f}; au[mi][ni] = (f32x4){0.f, 0.f, 0.f, 0.f}; }
        for (int k0 = 0; k0 < D; k0 += 32) {
            bf16x8 a[4], bg[2], bu[2];
#pragma unroll
            for (int mi = 0; mi < 4; ++mi) a[mi] = *(const bf16x8*)(ap[mi] + k0);
#pragma unroll
            for (int ni = 0; ni < 2; ++ni) { bg[ni] = *(const bf16x8*)(bp[0][ni] + k0); bu[ni] = *(const bf16x8*)(bp[1][ni] + k0); }
#pragma unroll
            for (int mi = 0; mi < 4; ++mi)
#pragma unroll
                for (int ni = 0; ni < 2; ++ni) { ag[mi][ni] = __builtin_amdgcn_mfma_f32_16x16x32_bf16(a[mi], bg[ni], ag[mi][ni], 0, 0, 0); au[mi][ni] = __builtin_amdgcn_mfma_f32_16x16x32_bf16(a[mi], bu[ni], au[mi][ni], 0, 0, 0); }
        }
        const int hr0 = tab[32 + e] + rb * 64;
#pragma unroll
        for (int mi = 0; mi < 4; ++mi)
#pragma unroll
            for (int ni = 0; ni < 2; ++ni)
#pragma unroll
                for (int q = 0; q < 4; ++q) { const int row = hr0 + 16 * mi + 4 * fq + q, colh = hb * 32 + 16 * ni + fr;
                    hid[(size_t)row * DEXP + colh] = (bf16_t)f2bf(silu_f(ag[mi][ni][q]) * au[mi][ni][q]); }
    }
}
__device__ __forceinline__ void p7_expert_down(const Params& p, LAS unsigned char* lds) {
    LAS int* tab = (LAS int*)lds; moe_tables(p, tab, 16);
    const int tid = threadIdx.x, lane = tid & 63, wave = tid >> 6, fr = lane & 15, fq = lane >> 4;
    const int gw = blockIdx.x * NWAVES + wave, NGW = gridDim.x * NWAVES, total = tab[96];
    const bf16_t* hid = (const bf16_t*)(p.ws + OFF_HID); const bf16_t* wd = (const bf16_t*)(p.ws + OFF_WD); bf16_t* yb = (bf16_t*)(p.ws + OFF_YB);
    const int* lslot = (const int*)(p.ws + OFF_LSLOT); const float* lw = (const float*)(p.ws + OFF_LW);
    for (int it = gw; it < total; it += NGW) {
        int e = 0;
#pragma unroll 1
        for (int q = 1; q < NEXP; ++q) if (it >= tab[64 + q]) e = q;
        const int r = it - tab[64 + e], rb = r >> 4, cb = r & 15, c = tab[e];
        const int hr0 = tab[32 + e] + rb * 64;
        const bf16_t* ap[4]; const bf16_t* bp[4];
#pragma unroll
        for (int mi = 0; mi < 4; ++mi) ap[mi] = hid + (size_t)(hr0 + 16 * mi + fr) * DEXP + 8 * fq;
#pragma unroll
        for (int ni = 0; ni < 4; ++ni) bp[ni] = wd + ((size_t)e * D + cb * 64 + 16 * ni + fr) * DEXP + 8 * fq;
        f32x4 acc[4][4];
#pragma unroll
        for (int mi = 0; mi < 4; ++mi)
#pragma unroll
            for (int ni = 0; ni < 4; ++ni) acc[mi][ni] = (f32x4){0.f, 0.f, 0.f, 0.f};
        for (int k0 = 0; k0 < DEXP; k0 += 32) {
            bf16x8 a[4], bb[4];
#pragma unroll
            for (int mi = 0; mi < 4; ++mi) a[mi] = *(const bf16x8*)(ap[mi] + k0);
#pragma unroll
            for (int ni = 0; ni < 4; ++ni) bb[ni] = *(const bf16x8*)(bp[ni] + k0);
#pragma unroll
            for (int mi = 0; mi < 4; ++mi)
#pragma unroll
                for (int ni = 0; ni < 4; ++ni) acc[mi][ni] = __builtin_amdgcn_mfma_f32_16x16x32_bf16(a[mi], bb[ni], acc[mi][ni], 0, 0, 0);
        }
#pragma unroll
        for (int mi = 0; mi < 4; ++mi)
#pragma unroll
            for (int q = 0; q < 4; ++q) { const int a = rb * 64 + 16 * mi + 4 * fq + q;
                if (a < c) { const int slot = lslot[e * LISTCAP + a]; const float w = lw[e * LISTCAP + a];
#pragma unroll
                    for (int ni = 0; ni < 4; ++ni) yb[(size_t)slot * D + cb * 64 + 16 * ni + fr] = (bf16_t)f2bf(acc[mi][ni][q] * w); } }
    }
}

__device__ __forceinline__ void p8_final(const Params& p) {
    const int tid = threadIdx.x, lane = tid & 63, wave = tid >> 6;
    const int gw = blockIdx.x * NWAVES + wave, NGW = gridDim.x * NWAVES;
    const float* x1 = (const float*)(p.ws + OFF_X1); const bf16_t* yb = (const bf16_t*)(p.ws + OFF_YB);
    for (int m = gw; m < NTOK; m += NGW) {
        const f32x4* xr = (const f32x4*)(x1 + (size_t)m * D) + lane;
        const u32x2* y0 = (const u32x2*)(yb + (size_t)(2 * m) * D) + lane; const u32x2* y1 = (const u32x2*)(yb + (size_t)(2 * m + 1) * D) + lane;
        f32x4 v[4]; float s = 0.f;
#pragma unroll
        for (int j = 0; j < 4; ++j) { v[j] = xr[64 * j]; const u32x2 a = y0[64 * j], b = y1[64 * j];
            v[j].x += bflo(a.x) + bflo(b.x); v[j].y += bfhi(a.x) + bfhi(b.x); v[j].z += bflo(a.y) + bflo(b.y); v[j].w += bfhi(a.y) + bfhi(b.y);
            s += (v[j].x * v[j].x + v[j].y * v[j].y) + (v[j].z * v[j].z + v[j].w * v[j].w); }
        const float rstd = rsqrtf(wave_sum(s) * (1.f / D) + EPS);
        f32x4* o = (f32x4*)(p.out + (size_t)m * D) + lane;
#pragma unroll
        for (int j = 0; j < 4; ++j) { const f32x4 g = *((const f32x4*)p.norm_f_w + lane + 64 * j); o[64 * j] = (f32x4){v[j].x * rstd * g.x, v[j].y * rstd * g.y, v[j].z * rstd * g.z, v[j].w * rstd * g.w}; }
    }
}

constexpr int NPHASES = 9;
#ifndef ONLY_PHASE
#define ONLY_PHASE -1
#endif
#define PH_ON(k) (ONLY_PHASE < 0 || ONLY_PHASE == (k))
__global__ void __launch_bounds__(NTHR, 2) fwd_megakernel(Params p) {
    extern __shared__ __attribute__((aligned(16))) unsigned char lds_raw[];
    LAS unsigned char* lds = (LAS unsigned char*)lds_raw;
    cg::grid_group grid = cg::this_grid();
    const int G = gridDim.x;
    const int lo = p.ph_lo, hi = p.ph_hi;
#define IN(k) (PH_ON(k) && lo <= (k) && (k) < hi)
#define SEAM(k) do { if ((k) + 1 < hi && lo <= (k)) grid.sync(); } while (0)
    if (IN(0)) p0_prologue(p, lds);
    SEAM(0);
    if (IN(1)) { pg8::Gemm g{(const bf16_t*)(p.ws + OFF_XN), (const bf16_t*)(p.ws + OFF_WT1), NTOK, N1, D}; pg8::StaticOrder S; S.init(NTOK, N1, G, (int)blockIdx.x);
                 pg8::EpiBf16 E{(bf16_t*)(p.ws + OFF_PROJ), N1}; pg8::gemm_phase(lds, g, S, E); }
    SEAM(1);
    if (IN(2)) p2_scans(p, lds);
    SEAM(2);
    if (IN(3)) { pg8::Gemm g{(const bf16_t*)(p.ws + OFF_XN), (const bf16_t*)(p.ws + OFF_WT3), NTOK, 4096, D}; pg8::StaticOrder S; S.init(NTOK, 4096, G, (int)blockIdx.x);
                 pg8::EpiMix E{(const bf16_t*)p.out, (const bf16_t*)p.out + (size_t)NTOK * D, (bf16_t*)(p.ws + OFF_MIX)}; pg8::gemm_phase(lds, g, S, E); }
    SEAM(3);
    if (IN(4)) { pg8::Gemm g{(const bf16_t*)(p.ws + OFF_MIX), (const bf16_t*)(p.ws + OFF_WTO), NTOK, D, D}; pg8::StaticOrder S; S.init(NTOK, D, G, (int)blockIdx.x);
                 pg8::EpiRes E{p.x, (float*)(p.ws + OFF_X1), D}; pg8::gemm_phase(lds, g, S, E); }
    SEAM(4);
    if (IN(5)) p5_router(p, lds);
    SEAM(5);
    if (IN(6)) p6_expert_up(p, lds);
    SEAM(6);
    if (IN(7)) p7_expert_down(p, lds);
    SEAM(7);
    if (IN(8)) p8_final(p);
#undef IN
#undef SEAM
}

extern "C" void kernel_launch(void* const* d_in, const int* in_sizes, int n_in, void* d_out, int out_size, void* d_ws, size_t ws_size, hipStream_t stream) {
    static int grid_blocks = 0;
    if (grid_blocks == 0) {
        if (n_in != 22 || in_sizes[0] != NTOK * D || out_size != NTOK * D || ws_size < WS_NEED) {
            fprintf(stderr, "kernel_launch: unexpected shapes (n_in %d, in0 %d, out %d, ws %zu, need %zu); nothing launched\n", n_in, n_in > 0 ? in_sizes[0] : -1, out_size, ws_size, (size_t)WS_NEED);
            grid_blocks = -1; return; }
        int dev = 0, cus = 0, per_cu = 0;
        hipGetDevice(&dev);
        hipDeviceGetAttribute(&cus, hipDeviceAttributeMultiprocessorCount, dev);
        if (hipFuncSetAttribute((const void*)fwd_megakernel, hipFuncAttributeMaxDynamicSharedMemorySize, LDS_BYTES) != hipSuccess) { fprintf(stderr, "kernel_launch: hipFuncSetAttribute failed\n"); grid_blocks = -1; return; }
        if (hipOccupancyMaxActiveBlocksPerMultiprocessor(&per_cu, (const void*)fwd_megakernel, NTHR, LDS_BYTES) != hipSuccess || per_cu < 1) { fprintf(stderr, "kernel_launch: occupancy query failed (%d)\n", per_cu); grid_blocks = -1; (void)hipGetLastError(); return; }
        if (per_cu > 1) per_cu = 1;
        grid_blocks = cus * per_cu;
    }
    if (grid_blocks < 0) return;
    hipMemsetAsync((char*)d_ws + OFF_CTL, 0, 65536, stream);
    Params p{};
    p.x = (const float*)d_in[0]; p.norm1_w = (const float*)d_in[1]; p.w_in = (const float*)d_in[2]; p.gla_w2_f = (const float*)d_in[3]; p.gla_b_f = (const float*)d_in[4];
    p.gla_w2_b = (const float*)d_in[5]; p.gla_b_b = (const float*)d_in[6]; p.gla_norm_w = (const float*)d_in[7]; p.conv_w = (const float*)d_in[8]; p.a_log_f = (const float*)d_in[9];
    p.dt_bias_f = (const float*)d_in[10]; p.a_log_b = (const float*)d_in[11]; p.dt_bias_b = (const float*)d_in[12]; p.gdn_norm_w = (const float*)d_in[13]; p.w_out = (const float*)d_in[14];
    p.norm2_w = (const float*)d_in[15]; p.w_group = (const float*)d_in[16]; p.w_router = (const float*)d_in[17]; p.w_gate = (const float*)d_in[18]; p.w_up = (const float*)d_in[19];
    p.w_down = (const float*)d_in[20]; p.norm_f_w = (const float*)d_in[21];
    p.out = (float*)d_out; p.ws = (unsigned char*)d_ws; p.ph_lo = 0; p.ph_hi = NPHASES;
    void* args[] = {&p};
    hipError_t e = hipLaunchCooperativeKernel((const void*)fwd_megakernel, dim3(grid_blocks), dim3(NTHR), args, LDS_BYTES, stream);
    if (e != hipSuccess) fprintf(stderr, "kernel_launch: cooperative launch failed: %s (grid %d)\n", hipGetErrorString(e), grid_blocks);
}
```

```cpp
#include <hip/hip_runtime.h>
#include <hip/hip_cooperative_groups.h>
#include <cstdio>
#include <cstdint>
namespace cg = cooperative_groups;

#define LAS __attribute__((address_space(3)))
typedef unsigned short bf16_t;
typedef short bf16x8 __attribute__((ext_vector_type(8)));
typedef float f32x4 __attribute__((ext_vector_type(4)));
typedef float f32x2 __attribute__((ext_vector_type(2)));
typedef unsigned u32x4 __attribute__((ext_vector_type(4)));
typedef unsigned u32x2 __attribute__((ext_vector_type(2)));

constexpr int D = 1024, NB = 8, SEQ = 2048, NTOK = NB * SEQ, DIN = 9280;
constexpr int N1 = 5376;
constexpr int C_GQ = 0, C_GK = 512, C_GV = 1024, C_DQ = 2048, C_DK = 3072, C_DV = 4096, C_GLR = 5120, C_DAB = 5152, N1_USED = 5184;
constexpr int NEXP = 32, DEXP = 256, LISTCAP = 16384, HID_ROWS = 40960;
constexpr float EPS = 1e-6f;
constexpr int LDS_BYTES = 147456;
constexpr int NTHR = 512, NWAVES = 8;

constexpr size_t OFF_CTL = 0;
constexpr size_t OFF_PROJ = 65536;
constexpr size_t SZ_PROJ = (size_t)NTOK * N1 * 2;
constexpr size_t OFF_XN = OFF_PROJ + SZ_PROJ;
constexpr size_t OFF_WT3 = OFF_XN + (size_t)NTOK * D * 2;
constexpr size_t OFF_WTO = OFF_WT3 + (size_t)4096 * D * 2;
constexpr size_t OFF_WT1 = OFF_WTO + (size_t)D * D * 2;
constexpr size_t OFF_END1 = OFF_WT1 + (size_t)N1 * D * 2;
constexpr size_t OFF_EG = OFF_WT1;
constexpr size_t OFF_DEC = OFF_EG + (size_t)2 * NTOK * 512 * 2;
constexpr size_t OFF_GT = OFF_DEC + (size_t)2 * NB * 4 * 64 * 128 * 4;
constexpr size_t OFF_BT = OFF_GT + (size_t)2 * NB * 8 * SEQ * 4;
constexpr size_t OFF_TAB_END = OFF_BT + (size_t)2 * NB * 8 * SEQ * 4;
constexpr size_t OFF_X1 = OFF_PROJ;
constexpr size_t OFF_MIX = OFF_X1 + (size_t)NTOK * D * 4;
constexpr size_t OFF_WGU = OFF_MIX + (size_t)NTOK * D * 2;
constexpr size_t OFF_WD = OFF_WGU + (size_t)NEXP * 512 * D * 2;
constexpr size_t OFF_HID = OFF_WD + (size_t)NEXP * D * DEXP * 2;
constexpr size_t OFF_OVL_END = OFF_HID + (size_t)HID_ROWS * DEXP * 2;
static_assert(OFF_OVL_END <= OFF_XN, "overlay exceeds the projection region");
constexpr size_t OFF_YB = OFF_XN;
constexpr size_t OFF_LSLOT = OFF_YB + (size_t)2 * NTOK * D * 2;
constexpr size_t OFF_LW = OFF_LSLOT + (size_t)NEXP * LISTCAP * 4;
constexpr size_t WS_NEED = (OFF_LW + (size_t)NEXP * LISTCAP * 4) > OFF_TAB_END ? (OFF_LW + (size_t)NEXP * LISTCAP * 4) : OFF_TAB_END;
static_assert(WS_NEED <= 268435456, "workspace budget");

struct Params {
    const float* x; const float* norm1_w; const float* w_in; const float* gla_w2_f; const float* gla_b_f; const float* gla_w2_b; const float* gla_b_b;
    const float* gla_norm_w; const float* conv_w; const float* a_log_f; const float* dt_bias_f; const float* a_log_b; const float* dt_bias_b; const float* gdn_norm_w;
    const float* w_out; const float* norm2_w; const float* w_group; const float* w_router; const float* w_gate; const float* w_up; const float* w_down; const float* norm_f_w;
    float* out; unsigned char* ws;
    int ph_lo, ph_hi;
};

__device__ __forceinline__ unsigned f2bf(float f) { unsigned u = __float_as_uint(f); return (u + 0x7fffu + ((u >> 16) & 1u)) >> 16; }
__device__ __forceinline__ float bf2f(unsigned short b) { return __uint_as_float(((unsigned)b) << 16); }
__device__ __forceinline__ unsigned pk2(float lo, float hi) { return f2bf(lo) | (f2bf(hi) << 16); }
__device__ __forceinline__ float bflo(unsigned w) { return __uint_as_float(w << 16); }
__device__ __forceinline__ float bfhi(unsigned w) { return __uint_as_float(w & 0xffff0000u); }
__device__ __forceinline__ float wave_sum(float v) {
#pragma unroll
    for (int o = 1; o < 64; o <<= 1) v += __shfl_xor(v, o);
    return v;
}
__device__ __forceinline__ float sigmoid_f(float x) { return 1.f / (1.f + __expf(-x)); }
__device__ __forceinline__ float silu_f(float x) { return x / (1.f + __expf(-x)); }
#define LDS_WAIT() asm volatile("s_waitcnt lgkmcnt(0)" ::: "memory")
__device__ __forceinline__ int lane_id() { return (int)__builtin_amdgcn_mbcnt_hi(~0u, __builtin_amdgcn_mbcnt_lo(~0u, 0u)); }
#define TID(wv) ((wv) * 64 + lane_id())

namespace pg8 {
constexpr int BM = 256, BK = 64, HALF = 128, HTB = HALF * BK * 2, STAGE_BYTES = 8 * HTB, NXCD = 8, WGM = 8;
__host__ __device__ __forceinline__ int lds_byte(int r, int c) { const int st = (r >> 4) * 2 + (c >> 5), rr = r & 15, cc = c & 31, ob = rr * 64 + cc * 2; return st * 1024 + (ob ^ (((ob >> 9) & 1) << 5)); }
__host__ __device__ __forceinline__ void stage_rc(int b, int& R, int& C) { const int st = b / 1024, sb = b % 1024, swz = sb ^ (((sb >> 9) & 1) << 5); R = (st >> 1) * 16 + swz / 64; C = (st & 1) * 32 + (swz % 64) / 2; }
__host__ __device__ __forceinline__ int perm32(int rho) { const int n = rho >> 4, i = rho & 15; return 8 * (i >> 2) + 4 * n + (i & 3); }
struct Unit { int pm, pn; };
struct Gemm { const bf16_t* A; const bf16_t* Bt; int M, N, K; };
struct StaticOrder {
    int nM, nN, nwg, G, c;
    __host__ __device__ void init(int M, int N, int G_, int c_) { nM = M / BM; nN = N / BM; nwg = nM * nN; G = G_; c = c_; }
    __host__ __device__ bool next(int i, Unit& u) const {
        const long L = (long)i * G + c; if (L >= nwg) return false;
        int wgid = (int)L; { const int q = nwg / NXCD, r = nwg % NXCD, xcd = wgid % NXCD, off = wgid / NXCD; wgid = (xcd < r ? xcd * (q + 1) : r * (q + 1) + (xcd - r) * q) + off; }
        const int nig = WGM * nN, gid = wgid / nig, fm = gid * WGM, gsz = (nM - fm) < WGM ? (nM - fm) : WGM;
        u.pm = fm + ((wgid % nig) % gsz); u.pn = (wgid % nig) / gsz; return true;
    }
    __device__ __forceinline__ void a_ready(const Unit&) const {}
    __device__ __forceinline__ void done(const Unit&) const {}
};
__device__ __forceinline__ unsigned cvt_pk_bf16(float lo, float hi) { unsigned r; asm volatile("v_cvt_pk_bf16_f32 %0, %1, %2" : "=v"(r) : "v"(lo), "v"(hi)); return r; }

struct EpiBf16 {
    static constexpr bool PERM = true;
    bf16_t* O; int ldc;
    __device__ __forceinline__ void operator()(const f32x4 (&acc)[2][2][4][2], const Unit& u, int wr, int wc, int fr, int fq) const {
        const int row0 = u.pm * BM + wr * 64 + fr, col0 = u.pn * BM + wc * 32 + 8 * fq;
#pragma unroll
        for (int ai = 0; ai < 2; ++ai)
#pragma unroll
            for (int m = 0; m < 4; ++m) { bf16_t* rowp = O + (size_t)(row0 + ai * HALF + m * 16) * ldc + col0;
#pragma unroll
                for (int bj = 0; bj < 2; ++bj) { const f32x4 v0 = acc[ai][bj][m][0], v1 = acc[ai][bj][m][1];
                    u32x4 w; w.x = cvt_pk_bf16(v0[0], v0[1]); w.y = cvt_pk_bf16(v0[2], v0[3]); w.z = cvt_pk_bf16(v1[0], v1[1]); w.w = cvt_pk_bf16(v1[2], v1[3]);
                    *(u32x4*)(rowp + bj * HALF) = w; } }
    }
};
struct EpiMix {
    static constexpr bool PERM = true;
    const bf16_t* ona; const bf16_t* onb; bf16_t* mixed;
    __device__ __forceinline__ void operator()(const f32x4 (&acc)[2][2][4][2], const Unit& u, int wr, int wc, int fr, int fq) const {
        const int row0 = u.pm * BM + wr * 64 + fr, mc0 = u.pn * 64 + wc * 16 + 4 * fq;
#pragma unroll
        for (int ai = 0; ai < 2; ++ai)
#pragma unroll
            for (int m = 0; m < 4; ++m) { const size_t off = (size_t)(row0 + ai * HALF + m * 16) * D + mc0;
                const u32x2 oa = *(const u32x2*)(ona + off), ob = *(const u32x2*)(onb + off);
                const float a4[4] = {bflo(oa.x), bfhi(oa.x), bflo(oa.y), bfhi(oa.y)}, b4[4] = {bflo(ob.x), bfhi(ob.x), bflo(ob.y), bfhi(ob.y)};
                float r[4];
#pragma unroll
                for (int i = 0; i < 4; ++i) r[i] = sigmoid_f(acc[ai][0][m][1][i]) * silu_f(acc[ai][0][m][0][i]) * a4[i] + sigmoid_f(acc[ai][1][m][1][i]) * silu_f(acc[ai][1][m][0][i]) * b4[i];
                u32x2 w; w.x = cvt_pk_bf16(r[0], r[1]); w.y = cvt_pk_bf16(r[2], r[3]);
                *(u32x2*)(mixed + off) = w; }
    }
};
struct EpiRes {
    static constexpr bool PERM = false;
    const float* base; float* C; int ldc;
    __device__ __forceinline__ void operator()(const f32x4 (&acc)[2][2][4][2], const Unit& u, int wr, int wc, int fr, int fq) const {
        const int row0 = u.pm * BM + wr * 64 + fr, col0 = u.pn * BM + wc * 32 + 4 * fq;
#pragma unroll
        for (int ai = 0; ai < 2; ++ai)
#pragma unroll
            for (int m = 0; m < 4; ++m) { const size_t off = (size_t)(row0 + ai * HALF + m * 16) * ldc + col0;
#pragma unroll
                for (int bj = 0; bj < 2; ++bj)
#pragma unroll
                    for (int n = 0; n < 2; ++n) { const f32x4 b = *(const f32x4*)(base + off + bj * HALF + n * 16); *(f32x4*)(C + off + bj * HALF + n * 16) = b + acc[ai][bj][m][n]; } }
    }
};

template <class Epi, class Sched>
__device__ __forceinline__ void gemm_phase(LAS unsigned char* lds, const Gemm g, const Sched& S, const Epi& E, int wv) {
    const int tid = wv * 64 + (int)__builtin_amdgcn_mbcnt_hi(~0u, __builtin_amdgcn_mbcnt_lo(~0u, 0u)), wid = wv, lane = tid & 63, wr = wid >> 2, wc = wid & 3, fr = lane & 15, fq = lane >> 4;
    const int K = g.K, nt = K / BK;
    unsigned voffA[2], voffB[2];
#pragma unroll
    for (int i = 0; i < 2; ++i) { int R, C; stage_rc(tid * 16 + i * 8192, R, C); const int Rb = Epi::PERM ? ((R & ~31) + perm32(R & 31)) : R;
        voffA[i] = (unsigned)(R * K + C) * 2u; voffB[i] = (unsigned)(Rb * K + C) * 2u; }
    const size_t kstep = (size_t)(BK * 2);
    const size_t hstep = (size_t)HALF * K * 2;
    const size_t tstep = 2 * hstep;
    const unsigned ldsw = (unsigned)wid * 1024u;
    const int aoff = lds_byte(wr * 64 + fr, fq * 8), boff = lds_byte(wc * 32 + fr, fq * 8);
#define PG8_SA(b, h) (((b) * 2 + (h)) * HTB)
#define PG8_SB(b, h) ((4 + (b) * 2 + (h)) * HTB)
#define PG8_STAGE(bufoff, gbase, voff) do { _Pragma("unroll") for (int _i = 0; _i < 2; ++_i) \
        __builtin_amdgcn_global_load_lds((const unsigned*)((const char*)(gbase) + (voff)[_i]), (LAS unsigned*)(lds + (bufoff) + ldsw + _i * 8192), 16, 0, 0); } while (0)
#define PG8_LDA(dst, b, h) do { _Pragma("unroll") for (int m = 0; m < 4; ++m) _Pragma("unroll") for (int k = 0; k < 2; ++k) dst[m][k] = *(const LAS bf16x8*)(lds + PG8_SA(b, h) + aoff + m * 2048 + k * 1024); } while (0)
#define PG8_LDB(dst, b, h) do { _Pragma("unroll") for (int n = 0; n < 2; ++n) _Pragma("unroll") for (int k = 0; k < 2; ++k) dst[n][k] = *(const LAS bf16x8*)(lds + PG8_SB(b, h) + boff + n * 2048 + k * 1024); } while (0)
#define PG8_MMA(ai, bj, At, Bt) do { __builtin_amdgcn_s_setprio(1); _Pragma("unroll") for (int m = 0; m < 4; ++m) _Pragma("unroll") for (int n = 0; n < 2; ++n) _Pragma("unroll") for (int k = 0; k < 2; ++k) \
        acc[ai][bj][m][n] = __builtin_amdgcn_mfma_f32_16x16x32_bf16(Bt[n][k], At[m][k], acc[ai][bj][m][n], 0, 0, 0); __builtin_amdgcn_s_setprio(0); } while (0)
#define PG8_WAIT_V(n) asm volatile("s_waitcnt vmcnt(" #n ")" ::: "memory")
#define PG8_WAIT_L(n) asm volatile("s_waitcnt lgkmcnt(" #n ")" ::: "memory")
#define PG8_BAR __builtin_amdgcn_s_barrier()
#define PG8_SCHED __builtin_amdgcn_sched_barrier(0)
    Unit cur, nxt; int ui = 0;
    if (!S.next(0, cur)) return;
    f32x4 acc[2][2][4][2];
#pragma unroll
    for (int a = 0; a < 2; ++a)
#pragma unroll
        for (int b = 0; b < 2; ++b)
#pragma unroll
            for (int m = 0; m < 4; ++m)
#pragma unroll
                for (int n = 0; n < 2; ++n) acc[a][b][m][n] = (f32x4){0.f, 0.f, 0.f, 0.f};
    bf16x8 At[4][2], B0[2][2], B1[2][2];
    const char* cA = (const char*)g.A + (size_t)cur.pm * tstep; const char* cB = (const char*)g.Bt + (size_t)cur.pn * tstep;
    S.a_ready(cur);
    PG8_STAGE(PG8_SB(0, 0), cB, voffB); PG8_STAGE(PG8_SA(0, 0), cA, voffA); PG8_STAGE(PG8_SB(0, 1), cB + hstep, voffB); PG8_STAGE(PG8_SA(0, 1), cA + hstep, voffA);
    if (wr == 1) PG8_BAR;
    PG8_WAIT_V(4); PG8_BAR;
    PG8_STAGE(PG8_SB(1, 0), cB + kstep, voffB); PG8_STAGE(PG8_SA(1, 0), cA + kstep, voffA); PG8_STAGE(PG8_SB(1, 1), cB + hstep + kstep, voffB);
    PG8_WAIT_V(6); PG8_BAR;
    for (;;) {
        const bool has_next = S.next(ui + 1, nxt);
        const char* nA = has_next ? (const char*)g.A + (size_t)nxt.pm * tstep : cA; const char* nB = has_next ? (const char*)g.Bt + (size_t)nxt.pn * tstep : cB;
        for (int t = 0; t < nt; t += 2) {
            const bool last = (t == nt - 2);
            const char* a1 = cA + (size_t)(t + 1) * kstep;
            const char* a2 = last ? nA : cA + (size_t)(t + 2) * kstep; const char* b2 = last ? nB : cB + (size_t)(t + 2) * kstep;
            const char* a3 = a2 + kstep; const char* b3 = b2 + kstep;
            if (last && has_next) S.a_ready(nxt);
            PG8_LDB(B0, 0, 0); PG8_SCHED; PG8_LDA(At, 0, 0); PG8_STAGE(PG8_SA(1, 1), a1 + hstep, voffA);
            PG8_WAIT_L(8); PG8_BAR; PG8_WAIT_L(0); PG8_MMA(0, 0, At, B0); PG8_BAR; PG8_SCHED;
            PG8_LDB(B1, 0, 1); PG8_STAGE(PG8_SB(0, 0), b2, voffB);
            PG8_BAR; PG8_WAIT_L(0); PG8_MMA(0, 1, At, B1); PG8_BAR;
            PG8_LDA(At, 0, 1); PG8_STAGE(PG8_SA(0, 0), a2, voffA);
            PG8_BAR; PG8_WAIT_L(0); PG8_MMA(1, 0, At, B0); PG8_BAR; PG8_SCHED;
            PG8_STAGE(PG8_SB(0, 1), b2 + hstep, voffB);
            PG8_WAIT_V(6); PG8_BAR; PG8_MMA(1, 1, At, B1); PG8_BAR;
            PG8_LDB(B0, 1, 0); PG8_SCHED; PG8_LDA(At, 1, 0); PG8_STAGE(PG8_SA(0, 1), a2 + hstep, voffA);
            PG8_WAIT_L(8); PG8_BAR; PG8_WAIT_L(0); PG8_MMA(0, 0, At, B0); PG8_BAR; PG8_SCHED;
            PG8_LDB(B1, 1, 1); PG8_STAGE(PG8_SB(1, 0), b3, voffB);
            PG8_BAR; PG8_WAIT_L(0); PG8_MMA(0, 1, At, B1); PG8_BAR;
            PG8_LDA(At, 1, 1); PG8_STAGE(PG8_SA(1, 0), a3, voffA);
            PG8_BAR; PG8_WAIT_L(0); PG8_MMA(1, 0, At, B0); PG8_BAR; PG8_SCHED;
            PG8_STAGE(PG8_SB(1, 1), b3 + hstep, voffB);
            PG8_WAIT_V(6); PG8_BAR; PG8_MMA(1, 1, At, B1); PG8_BAR;
        }
        E(acc, cur, wr, wc, fr, fq); S.done(cur);
        if (!has_next) break;
#pragma unroll
        for (int a = 0; a < 2; ++a)
#pragma unroll
            for (int b = 0; b < 2; ++b)
#pragma unroll
                for (int m = 0; m < 4; ++m)
#pragma unroll
                    for (int n = 0; n < 2; ++n) acc[a][b][m][n] = (f32x4){0.f, 0.f, 0.f, 0.f};
        cur = nxt; cA = nA; cB = nB; ++ui;
    }
    PG8_WAIT_V(0);
    if (wr == 0) PG8_BAR;
    PG8_BAR;
#undef PG8_SA
#undef PG8_SB
#undef PG8_STAGE
#undef PG8_LDA
#undef PG8_LDB
#undef PG8_MMA
#undef PG8_WAIT_V
#undef PG8_WAIT_L
#undef PG8_BAR
#undef PG8_SCHED
}
}

template <class RowPtr>
__device__ __forceinline__ void transpose_item(const float* W, int ldw, int k0, int n0, const float* kscale, LAS float* scr, int lane, const RowPtr& rowptr) {
#pragma unroll 8
    for (int i = 0; i < 32; ++i) { const int kk = 2 * i + (lane >> 5); float v = W[(size_t)(k0 + kk) * ldw + n0 + (lane & 31)]; if (kscale) v *= kscale[k0 + kk]; scr[kk * 33 + (lane & 31)] = v; }
    LDS_WAIT();
    const int c = lane & 7;
#pragma unroll
    for (int j = 0; j < 4; ++j) { const int n = (lane >> 3) + 8 * j; const LAS float* s = scr + (8 * c) * 33 + n;
        u32x4 o; o.x = pk2(s[0 * 33], s[1 * 33]); o.y = pk2(s[2 * 33], s[3 * 33]); o.z = pk2(s[4 * 33], s[5 * 33]); o.w = pk2(s[6 * 33], s[7 * 33]);
        *(u32x4*)(rowptr(n0 + n) + k0 + 8 * c) = o; }
    LDS_WAIT();
}

struct WinRow {
    bf16_t* wt1; bf16_t* wt3;
    __device__ __forceinline__ bf16_t* operator()(int c) const {
        if (c < 2048) return wt1 + (size_t)c * D;
        if (c < 3072) { const int cc = c - 2048; return wt3 + (size_t)(256 * (cc >> 6) + 8 * ((cc & 63) >> 2) + (cc & 3)) * D; }
        if (c < 3104) return wt1 + (size_t)(C_GLR + (c - 3072)) * D;
        if (c < 6176) return wt1 + (size_t)(C_DQ + (c - 3104)) * D;
        if (c < 7200) { const int cc = c - 6176; return wt3 + (size_t)(256 * (cc >> 6) + 128 + 8 * ((cc & 63) >> 2) + (cc & 3)) * D; }
        if (c < 7232) return wt1 + (size_t)(C_DAB + (c - 7200)) * D;
        if (c < 8256) { const int cc = c - 7232; return wt3 + (size_t)(256 * (cc >> 6) + 8 * ((cc & 63) >> 2) + 4 + (cc & 3)) * D; }
        { const int cc = c - 8256; return wt3 + (size_t)(256 * (cc >> 6) + 128 + 8 * ((cc & 63) >> 2) + 4 + (cc & 3)) * D; }
    }
};
struct PlainRow { bf16_t* base; int K; __device__ __forceinline__ bf16_t* operator()(int c) const { return base + (size_t)c * K; } };
struct GuRow { bf16_t* base; int up; __device__ __forceinline__ bf16_t* operator()(int c) const { return base + (size_t)(8 * (c >> 2) + 4 * up + (c & 3)) * D; } };

__device__ __forceinline__ void p0_prologue(const Params& p, LAS unsigned char* lds, int wv) {
    const int tid = TID(wv), lane = tid & 63, wave = wv;
    const int gw = blockIdx.x * NWAVES + wave, NGW = gridDim.x * NWAVES;
    LAS float* scr = (LAS float*)(lds + wave * 8448);
    bf16_t* wt1 = (bf16_t*)(p.ws + OFF_WT1); bf16_t* wt3 = (bf16_t*)(p.ws + OFF_WT3); bf16_t* wto = (bf16_t*)(p.ws + OFF_WTO); bf16_t* xn = (bf16_t*)(p.ws + OFF_XN);
    const WinRow wr{wt1, wt3};
    constexpr int I_IN = 16 * (DIN / 32), I_OUT = 16 * (D / 32);
    for (int it = gw; it < I_IN + I_OUT; it += NGW) {
        if (it < I_IN) { const int kb = it / (DIN / 32), nb = it % (DIN / 32); transpose_item(p.w_in, DIN, kb * 64, nb * 32, p.norm1_w, scr, lane, wr); }
        else { const int r = it - I_IN, kb = r / (D / 32), nb = r % (D / 32); transpose_item(p.w_out, D, kb * 64, nb * 32, nullptr, scr, lane, PlainRow{wto, D}); }
    }
    { const int gt = blockIdx.x * NTHR + tid, NGT = gridDim.x * NTHR; u32x4* z = (u32x4*)(wt1 + (size_t)N1_USED * D); const int nz = (N1 - N1_USED) * D / 8;
      for (int i = gt; i < nz; i += NGT) z[i] = (u32x4){0u, 0u, 0u, 0u}; }
    for (int m = gw; m < NTOK; m += NGW) {
        const f32x4* xr = (const f32x4*)(p.x + (size_t)m * D) + lane;
        f32x4 v[4]; float s = 0.f;
#pragma unroll
        for (int j = 0; j < 4; ++j) { v[j] = xr[64 * j]; s += (v[j].x * v[j].x + v[j].y * v[j].y) + (v[j].z * v[j].z + v[j].w * v[j].w); }
        const float rstd = rsqrtf(wave_sum(s) * (1.f / D) + EPS);
        u32x2* o8 = (u32x2*)(xn + (size_t)m * D) + lane;
#pragma unroll
        for (int j = 0; j < 4; ++j) { u32x2 w; w.x = pk2(v[j].x * rstd, v[j].y * rstd); w.y = pk2(v[j].z * rstd, v[j].w * rstd); o8[64 * j] = w; }
    }
}

__device__ __forceinline__ void p1b_conv_item(const Params& p, int b, int part, int h, int wv) {
    const int tid = TID(wv), lane = tid & 63, wave = wv;
    const int ch = part * 1024 + h * 128 + 2 * lane;
    bf16_t* base = (bf16_t*)(p.ws + OFF_PROJ) + (size_t)b * SEQ * N1 + C_DQ + ch;
    float cw0[5], cw1[5];
#pragma unroll
    for (int j = 0; j < 5; ++j) { cw0[j] = p.conv_w[j * 3072 + ch]; cw1[j] = p.conv_w[j * 3072 + ch + 1]; }
    const int s0 = wave * 256, s1 = s0 + 256;
    const unsigned hm2 = (s0 >= 2) ? *(const unsigned*)(base + (size_t)(s0 - 2) * N1) : 0u, hm1 = (s0 >= 1) ? *(const unsigned*)(base + (size_t)(s0 - 1) * N1) : 0u;
    const unsigned hp0 = (s1 < SEQ) ? *(const unsigned*)(base + (size_t)s1 * N1) : 0u, hp1 = (s1 + 1 < SEQ) ? *(const unsigned*)(base + (size_t)(s1 + 1) * N1) : 0u;
    unsigned raw[12];
    raw[8] = hm2; raw[9] = hm1; raw[10] = *(const unsigned*)(base + (size_t)s0 * N1); raw[11] = *(const unsigned*)(base + (size_t)(s0 + 1) * N1);
    asm volatile("s_waitcnt vmcnt(0)" ::: "memory");
    __syncthreads();
    const float qs = part == 0 ? 0.08838834764831845f : 1.f;
    for (int t0 = s0; t0 < s1; t0 += 8) {
#pragma unroll
        for (int j = 0; j < 4; ++j) raw[j] = raw[8 + j];
#pragma unroll
        for (int j = 0; j < 8; ++j) { const int t = t0 + 2 + j; raw[4 + j] = (t < s1) ? *(const unsigned*)(base + (size_t)t * N1) : (t == s1 ? hp0 : hp1); }
        float a0[8], a1[8], ss[8];
#pragma unroll
        for (int j = 0; j < 8; ++j) { float x0 = 0.f, x1 = 0.f;
#pragma unroll
            for (int q = 0; q < 5; ++q) { x0 += cw0[q] * bflo(raw[j + q]); x1 += cw1[q] * bfhi(raw[j + q]); }
            a0[j] = silu_f(x0); a1[j] = silu_f(x1); ss[j] = a0[j] * a0[j] + a1[j] * a1[j]; }
        if (part < 2) {
#pragma unroll
            for (int j = 0; j < 8; ++j) { const float rs = rsqrtf(wave_sum(ss[j]) + EPS) * qs; a0[j] *= rs; a1[j] *= rs; } }
#pragma unroll
        for (int j = 0; j < 8; ++j) *(unsigned*)(base + (size_t)(t0 + j) * N1) = pk2(a0[j], a1[j]);
    }
}
__device__ __forceinline__ float log_sigmoid_f(float z) { return fminf(z, 0.f) - log1pf(expf(-fabsf(z))); }
__device__ __forceinline__ float softplus_f(float z) { return z > 20.f ? z : log1pf(expf(z)); }

__device__ __forceinline__ void p1b_prepass(const Params& p, int wv) {
    const int tid = TID(wv), lane = tid & 63;
    const bf16_t* proj = (const bf16_t*)(p.ws + OFF_PROJ);
    { float* gt = (float*)(p.ws + OFF_GT); float* bt = (float*)(p.ws + OFF_BT);
      for (int idx = blockIdx.x * NTHR + tid; idx < 2 * NB * 8 * SEQ; idx += gridDim.x * NTHR) {
          const int t = idx & 2047, h = (idx >> 11) & 7, b = (idx >> 14) & 7, dir = idx >> 17;
          const bf16_t* rp = proj + (size_t)(b * SEQ + t) * N1 + C_DAB;
          const float araw = bf2f(rp[dir * 8 + h]), braw = bf2f(rp[16 + dir * 8 + h]);
          const float A = -expf(dir ? p.a_log_b[h] : p.a_log_f[h]), dtb = dir ? p.dt_bias_b[h] : p.dt_bias_f[h];
          float Gc = A * softplus_f(araw + dtb);
#pragma unroll
          for (int o = 1; o < 32; o <<= 1) { const float nb = dir ? __shfl_down(Gc, o, 32) : __shfl_up(Gc, o, 32); const bool ok = dir ? ((lane & 31) + o < 32) : ((lane & 31) >= o); if (ok) Gc += nb; }
          gt[idx] = Gc; bt[idx] = 1.f / (1.f + expf(-braw)); } }
    { bf16_t* eg = (bf16_t*)(p.ws + OFF_EG); float* dec = (float*)(p.ws + OFF_DEC);
      const int d = tid & 127;
      for (int grp = blockIdx.x; grp < 1024; grp += gridDim.x) {
          const int it = grp * 4 + (tid >> 7), c = it & 63, h = (it >> 6) & 3, b = (it >> 8) & 7, dir = it >> 11;
          const float* w2 = dir ? p.gla_w2_b : p.gla_w2_f; const float bias = (dir ? p.gla_b_b : p.gla_b_f)[h * 128 + d];
          float wc[16];
#pragma unroll
          for (int r = 0; r < 16; ++r) wc[r] = w2[r * 512 + h * 128 + d];
          float cum = 0.f;
          for (int i0 = 0; i0 < 32; i0 += 4) {
              u32x4 g[4][2];
#pragma unroll
              for (int q = 0; q < 4; ++q) { const int i = i0 + q, t = dir ? c * 32 + 31 - i : c * 32 + i; const u32x4* gp = (const u32x4*)(proj + (size_t)(b * SEQ + t) * N1 + C_GLR + dir * 16); g[q][0] = gp[0]; g[q][1] = gp[1]; }
#pragma unroll
              for (int q = 0; q < 4; ++q) { const int i = i0 + q, t = dir ? c * 32 + 31 - i : c * 32 + i; float z = bias;
#pragma unroll
                  for (int e = 0; e < 4; ++e) { z += bflo(g[q][0][e]) * wc[2 * e] + bfhi(g[q][0][e]) * wc[2 * e + 1]; z += bflo(g[q][1][e]) * wc[8 + 2 * e] + bfhi(g[q][1][e]) * wc[8 + 2 * e + 1]; }
                  cum += log_sigmoid_f(z) * (1.f / 16.f);
                  eg[((size_t)dir * NTOK + (size_t)b * SEQ + t) * 512 + h * 128 + d] = (bf16_t)f2bf(expf(cum)); }
          }
          dec[((((size_t)dir * NB + b) * 4 + h) * 64 + c) * 128 + d] = expf(cum);
      } }
    for (int it = blockIdx.x; it < NB * 3 * 8; it += gridDim.x) { __syncthreads(); p1b_conv_item(p, it / 24, (it % 24) >> 3, it & 7, wv); }
}

typedef float f32x16 __attribute__((ext_vector_type(16)));
typedef short s16x4 __attribute__((ext_vector_type(4)));
typedef __bf16 bf16x2_t __attribute__((ext_vector_type(2)));
#define MFMA32(a, b, c) __builtin_amdgcn_mfma_f32_32x32x16_bf16((a), (b), (c), 0, 0, 0)
__device__ __forceinline__ unsigned cvt2(float a, float b) { const f32x2 v = {a, b}; return __builtin_bit_cast(unsigned, __builtin_convertvector(v, bf16x2_t)); }
template <int S_> __device__ __forceinline__ bf16x8 pack8(const f32x16& x) {
    u32x4 q; q.x = cvt2(x[8 * S_], x[8 * S_ + 1]); q.y = cvt2(x[8 * S_ + 2], x[8 * S_ + 3]); q.z = cvt2(x[8 * S_ + 4], x[8 * S_ + 5]); q.w = cvt2(x[8 * S_ + 6], x[8 * S_ + 7]);
    return __builtin_bit_cast(bf16x8, q);
}
__device__ __forceinline__ int crow(int reg, int h) { return (reg & 3) + 8 * (reg >> 2) + 4 * h; }
__device__ __forceinline__ unsigned offb(unsigned row, unsigned ch) { return 256u * row + 16u * (ch ^ (((row & 3u) << 2) | ((row >> 2) & 3u))); }
__device__ __forceinline__ bf16x8 rowfrag_nat(const LAS unsigned char* img, int ks, int lane) { return *(const LAS bf16x8*)(img + offb(lane & 31, 2 * ks + (lane >> 5))); }
__device__ __forceinline__ bf16x8 rowfrag_perm(const LAS unsigned char* img, int ks, int lane) {
    const unsigned row = lane & 31, h8 = 8u * (lane >> 5);
    const s16x4 lo = *(const LAS s16x4*)(img + offb(row, 2 * ks) + h8), hi = *(const LAS s16x4*)(img + offb(row, 2 * ks + 1) + h8);
    return __builtin_shufflevector(lo, hi, 0, 1, 2, 3, 4, 5, 6, 7);
}
__device__ __forceinline__ bf16x8 trfrag_perm(const LAS unsigned char* img, int c, int ks, int lane) {
    const unsigned h = lane >> 5, blk = (lane >> 4) & 1, q = (lane & 15) >> 2, pp = lane & 3;
    const unsigned a0 = offb(16 * ks + 4 * h + q, 4 * c + 2 * blk + (pp >> 1)) + 8 * (pp & 1), a1 = offb(16 * ks + 4 * h + 8 + q, 4 * c + 2 * blk + (pp >> 1)) + 8 * (pp & 1);
    const s16x4 lo = __builtin_amdgcn_ds_read_tr16_b64_v4i16((LAS s16x4*)(img + a0)), hi = __builtin_amdgcn_ds_read_tr16_b64_v4i16((LAS s16x4*)(img + a1));
    return __builtin_shufflevector(lo, hi, 0, 1, 2, 3, 4, 5, 6, 7);
}
__device__ __forceinline__ f32x16 zero16() { f32x16 z;
#pragma unroll
    for (int i = 0; i < 16; ++i) z[i] = 0.f; return z; }

__device__ __forceinline__ void load_prev(const bf16_t* ochunk  , unsigned loff  , bool second, u32x4 (&prev)[2]) {
    const u32x4* op = (const u32x4*)((const char*)ochunk + loff);
    if (second) { prev[0] = __builtin_nontemporal_load(op); prev[1] = __builtin_nontemporal_load(op + 1); }
    else { prev[0] = (u32x4){0u, 0u, 0u, 0u}; prev[1] = prev[0]; }
}
__device__ __forceinline__ void store_o(bf16_t* ochunk, unsigned loff, const f32x16& o, int lane, LAS float* scr, const u32x4 (&prev)[2]) {
    const int hh = lane >> 5, r = lane & 31;
#pragma unroll
    for (int reg = 0; reg < 16; ++reg) scr[crow(reg, hh) * 32 + r] = o[reg];
    asm volatile("s_waitcnt lgkmcnt(0)" ::: "memory");
    const LAS f32x4* sp = (const LAS f32x4*)(scr + (lane >> 1) * 32 + 16 * (lane & 1));
    const f32x4 a0 = sp[0], a1 = sp[1], a2 = sp[2], a3 = sp[3];
    u32x4 w0, w1;
    w0.x = cvt2(a0.x + bflo(prev[0].x), a0.y + bfhi(prev[0].x)); w0.y = cvt2(a0.z + bflo(prev[0].y), a0.w + bfhi(prev[0].y));
    w0.z = cvt2(a1.x + bflo(prev[0].z), a1.y + bfhi(prev[0].z)); w0.w = cvt2(a1.z + bflo(prev[0].w), a1.w + bfhi(prev[0].w));
    w1.x = cvt2(a2.x + bflo(prev[1].x), a2.y + bfhi(prev[1].x)); w1.y = cvt2(a2.z + bflo(prev[1].y), a2.w + bfhi(prev[1].y));
    w1.z = cvt2(a3.x + bflo(prev[1].z), a3.y + bfhi(prev[1].z)); w1.w = cvt2(a3.z + bflo(prev[1].w), a3.w + bfhi(prev[1].w));
    u32x4* op = (u32x4*)((char*)ochunk + loff);
    op[0] = w0; op[1] = w1;
    asm volatile("s_waitcnt lgkmcnt(0)" ::: "memory");
}
__device__ __forceinline__ void rowvals16(const LAS float* tab, int hh, int z, float (&out)[16]) {
#pragma unroll
    for (int g = 0; g < 4; ++g) { const f32x4 v = *(const LAS f32x4*)(tab + z + 8 * g + 4 * hh);
#pragma unroll
        for (int e = 0; e < 4; ++e) out[4 * g + e] = v[e]; }
}
#define SCHED_FENCE() __builtin_amdgcn_sched_barrier(0)
#define LAUNDER(v) asm volatile("" : "+v"(v))

constexpr int GLA_BUF = 3 * 8192 + 512, GLA_DIR = 2 * GLA_BUF, SCR_OFF = 110592;
__device__ __forceinline__ void p2_gla_chunked(const Params& p, int b, int h, int half, LAS unsigned char* lds, int wv) {
    const int tid = TID(wv), lane = tid & 63, wave = wv, dir = wave >> 2, ct = wave & 3, hh = lane >> 5, r = lane & 31, dtid = tid & 255;
    LAS unsigned char* dbase = lds + dir * GLA_DIR; LAS float* scr = (LAS float*)(lds + SCR_OFF + 4096 * wave);
    const bf16_t* proj = (const bf16_t*)(p.ws + OFF_PROJ); const bf16_t* eg = (const bf16_t*)(p.ws + OFF_EG) + (size_t)dir * NTOK * 512;
    const float* dect = (const float*)(p.ws + OFF_DEC) + (((size_t)dir * NB + b) * 4 + h) * 64 * 128;
    bf16_t* ocol = (bf16_t*)p.out + (size_t)b * SEQ * D + h * 256 + half * 128 + ct * 32;
    const unsigned o_loff = (unsigned)((dir ? 31 - (lane >> 1) : (lane >> 1)) * D * 2 + 32 * (lane & 1));
    unsigned p_loff[2], e_loff[2];
#pragma unroll
    for (int j = 0; j < 2; ++j) { const int id = dtid + 256 * j, row = id >> 4, ch = id & 15, tl = dir ? 31 - row : row; p_loff[j] = (unsigned)(tl * N1 * 2 + ch * 16); e_loff[j] = (unsigned)(tl * 1024 + ch * 16); }
    unsigned v_loff[2];
#pragma unroll
    for (int jj = 0; jj < 2; ++jj) { const int blk = ct + 4 * jj, row = 4 * blk + (lane >> 4), ch = (lane & 15) ^ (((row & 3) << 2) | ((row >> 2) & 3)), tl = dir ? 31 - row : row; v_loff[jj] = (unsigned)(tl * N1 * 2 + ch * 16); }
    u32x4 rq[2], rk[2], re[2]; float rdec = 0.f;
    auto dma_v = [&](int n, int bi) {
        const int c = dir ? 63 - n : n; const char* vb = (const char*)(proj + ((size_t)b * SEQ + c * 32) * N1 + C_GV + h * 256 + half * 128);
#pragma unroll
        for (int jj = 0; jj < 2; ++jj) __builtin_amdgcn_global_load_lds((const unsigned*)(vb + v_loff[jj]), (LAS unsigned*)(dbase + bi * GLA_BUF + 16384 + (ct + 4 * jj) * 1024), 16, 0, 0);
    };
    auto issue = [&](int n) {
        const int c = dir ? 63 - n : n; const char* rb = (const char*)(proj + ((size_t)b * SEQ + c * 32) * N1 + h * 128); const char* eb = (const char*)(eg + ((size_t)b * SEQ + c * 32) * 512 + h * 128);
#pragma unroll
        for (int j = 0; j < 2; ++j) { rq[j] = *(const u32x4*)(rb + C_GQ * 2 + p_loff[j]); rk[j] = *(const u32x4*)(rb + C_GK * 2 + p_loff[j]); re[j] = *(const u32x4*)(eb + e_loff[j]); }
        if (dtid < 128) rdec = dect[c * 128 + dtid];
    };
    auto commit = [&](int bi) {
        LAS unsigned char* bb = dbase + bi * GLA_BUF;
#pragma unroll
        for (int j = 0; j < 2; ++j) { const int id = dtid + 256 * j, row = id >> 4, ch = id & 15; const unsigned o = offb(row, ch);
            u32x4 qd, ki;
#pragma unroll
            for (int e = 0; e < 4; ++e) { const float e0 = bflo(re[j][e]), e1 = bfhi(re[j][e]);
                qd[e] = cvt2(bflo(rq[j][e]) * e0 * 0.08838834764831845f, bfhi(rq[j][e]) * e1 * 0.08838834764831845f);
                ki[e] = cvt2(bflo(rk[j][e]) * __builtin_amdgcn_rcpf(e0), bfhi(rk[j][e]) * __builtin_amdgcn_rcpf(e1)); }
            *(LAS u32x4*)(bb + o) = qd; *(LAS u32x4*)(bb + 8192 + o) = ki; }
        if (dtid < 128) *(LAS float*)(bb + 24576 + dtid * 4) = rdec;
    };
    f32x16 S[4];
#pragma unroll
    for (int i = 0; i < 4; ++i) S[i] = zero16();
    __syncthreads();
    issue(0); dma_v(0, 0); commit(0);
    __syncthreads();
    for (int n = 0; n < 64; ++n) {
        const LAS unsigned char* QD = dbase + (n & 1) * GLA_BUF; const LAS unsigned char* KI = QD + 8192; const LAS unsigned char* VV = QD + 16384; const LAS float* DEC = (const LAS float*)(QD + 24576);
        const int c = dir ? 63 - n : n; bf16_t* ochunk = ocol + (size_t)c * 32 * D;
        if (n + 1 < 64) { issue(n + 1); dma_v(n + 1, (n + 1) & 1); }
        f32x16 sc = zero16();
        int l1 = lane; LAUNDER(l1);
#pragma unroll
        for (int ks = 0; ks < 4; ++ks) sc = MFMA32(rowfrag_nat(KI, ks, l1), rowfrag_nat(QD, ks, l1), sc);
        SCHED_FENCE();
#pragma unroll
        for (int ks = 4; ks < 8; ++ks) sc = MFMA32(rowfrag_nat(KI, ks, l1), rowfrag_nat(QD, ks, l1), sc);
#pragma unroll
        for (int reg = 0; reg < 16; ++reg) if (crow(reg, hh) > r) sc[reg] = 0.f;
        SCHED_FENCE();
        u32x4 prev[2]; load_prev(ochunk, o_loff, n >= 32, prev);
        int l2 = lane; LAUNDER(l2);
        const bf16x8 vt0 = trfrag_perm(VV, ct, 0, l2), vt1 = trfrag_perm(VV, ct, 1, l2);
        f32x16 o = zero16();
        o = MFMA32(pack8<0>(sc), vt0, o); o = MFMA32(pack8<1>(sc), vt1, o);
#pragma unroll
        for (int dt = 0; dt < 2; ++dt) { o = MFMA32(rowfrag_perm(QD, 2 * dt, l2), pack8<0>(S[dt]), o); o = MFMA32(rowfrag_perm(QD, 2 * dt + 1, l2), pack8<1>(S[dt]), o); }
        SCHED_FENCE();
#pragma unroll
        for (int dt = 2; dt < 4; ++dt) { o = MFMA32(rowfrag_perm(QD, 2 * dt, l2), pack8<0>(S[dt]), o); o = MFMA32(rowfrag_perm(QD, 2 * dt + 1, l2), pack8<1>(S[dt]), o); }
        SCHED_FENCE();
        int l3 = lane; LAUNDER(l3);
#pragma unroll
        for (int dt = 0; dt < 4; ++dt) { f32x16 ds = S[dt];
            ds = MFMA32(trfrag_perm(KI, dt, 0, l3), vt0, ds); ds = MFMA32(trfrag_perm(KI, dt, 1, l3), vt1, ds);
#pragma unroll
            for (int g = 0; g < 4; ++g) { const f32x4 dv = *(const LAS f32x4*)(DEC + 32 * dt + 8 * g + 4 * hh);
#pragma unroll
                for (int e = 0; e < 4; ++e) ds[4 * g + e] *= dv[e]; }
            S[dt] = ds; }
        SCHED_FENCE();
        store_o(ochunk, o_loff, o, lane, scr, prev);
        if (n + 1 < 64) commit((n + 1) & 1);
        __syncthreads();
    }
}

constexpr int GDN_BUF = 3 * 8192 + 256, GDN_DIR = 2 * GDN_BUF + 4096;
__device__ __forceinline__ void p2_gdn_chunked(const Params& p, int b, int h, LAS unsigned char* lds, int wv) {
    const int tid = TID(wv), lane = tid & 63, wave = wv, dir = wave >> 2, ct = wave & 3, hh = lane >> 5, r = lane & 31, dtid = tid & 255;
    LAS unsigned char* dbase = lds + dir * GDN_DIR; LAS unsigned char* TF = dbase + 2 * GDN_BUF; LAS float* scr = (LAS float*)(lds + SCR_OFF + 4096 * wave);
    const bf16_t* proj = (const bf16_t*)(p.ws + OFF_PROJ);
    const float* gtab = (const float*)(p.ws + OFF_GT) + (((size_t)dir * NB + b) * 8 + h) * SEQ; const float* btab = (const float*)(p.ws + OFF_BT) + (((size_t)dir * NB + b) * 8 + h) * SEQ;
    bf16_t* ocol = (bf16_t*)p.out + (size_t)NTOK * D + (size_t)b * SEQ * D + h * 128 + ct * 32;
    const unsigned o_loff = (unsigned)((dir ? 31 - (lane >> 1) : (lane >> 1)) * D * 2 + 32 * (lane & 1));
    unsigned d_loff[2];
#pragma unroll
    for (int jj = 0; jj < 2; ++jj) { const int blk = ct + 4 * jj, row = 4 * blk + (lane >> 4), ch = (lane & 15) ^ (((row & 3) << 2) | ((row >> 2) & 3)), tl = dir ? 31 - row : row; d_loff[jj] = (unsigned)(tl * N1 * 2 + ch * 16); }
    const unsigned g_loff = (unsigned)((dir ? 31 - (dtid & 31) : (dtid & 31)) * 4);
    float rg = 0.f;
    auto dma = [&](int n, int bi) {
        const int c = dir ? 63 - n : n; const char* rb = (const char*)(proj + ((size_t)b * SEQ + c * 32) * N1 + h * 128);
#pragma unroll
        for (int tile = 0; tile < 3; ++tile)
#pragma unroll
            for (int jj = 0; jj < 2; ++jj)
                __builtin_amdgcn_global_load_lds((const unsigned*)(rb + (tile == 0 ? C_DK : tile == 1 ? C_DQ : C_DV) * 2 + d_loff[jj]), (LAS unsigned*)(dbase + bi * GDN_BUF + tile * 8192 + (ct + 4 * jj) * 1024), 16, 0, 0);
    };
    auto issue_g = [&](int n) { const int c = dir ? 63 - n : n; if (dtid < 64) rg = *(const float*)((const char*)((dtid < 32 ? gtab : btab) + c * 32) + g_loff); };
    auto commit_g = [&](int bi) { if (dtid < 64) *(LAS float*)(dbase + bi * GDN_BUF + 24576 + dtid * 4) = rg; };
    f32x16 S[4];
#pragma unroll
    for (int i = 0; i < 4; ++i) S[i] = zero16();
    __syncthreads();
    dma(0, 0); issue_g(0); commit_g(0);
    __syncthreads();
    for (int n = 0; n < 64; ++n) {
        const LAS unsigned char* KN = dbase + (n & 1) * GDN_BUF; const LAS unsigned char* QN = KN + 8192; const LAS unsigned char* VV = KN + 16384; const LAS float* GS = (const LAS float*)(KN + 24576); const LAS float* BS = GS + 32;
        const int c = dir ? 63 - n : n; bf16_t* ochunk = ocol + (size_t)c * 32 * D;
        bf16x8 at0, at1; f32x16 o;
        {
            const float Gc = GS[r];
            if (ct == 0) {
                f32x16 kk = zero16();
                int l0 = lane; LAUNDER(l0);
#pragma unroll
                for (int ks = 0; ks < 8; ++ks) { const bf16x8 f = rowfrag_nat(KN, ks, l0); kk = MFMA32(f, f, kk); }
                f32x16 X, Xt, Pt;
                { float Ga[16], Ba[16]; const float Bc = BS[r]; int z0 = 0; LAUNDER(z0); rowvals16(GS, hh, z0, Ga); rowvals16(BS, hh, z0, Ba);
#pragma unroll
                  for (int reg = 0; reg < 16; ++reg) { const int a = crow(reg, hh);
                      X[reg] = (r < a) ? -Ba[reg] * kk[reg] * __expf(Ga[reg] - Gc) : 0.f;
                      Xt[reg] = (a < r) ? -Bc * kk[reg] * __expf(Gc - Ga[reg]) : 0.f;
                      Pt[reg] = Xt[reg] + (a == r ? 1.f : 0.f); } }
#pragma unroll
                for (int lvl = 0; lvl < 4; ++lvl) {
                    const bf16x8 x0 = pack8<0>(X), x1 = pack8<1>(X), xt0 = pack8<0>(Xt), xt1 = pack8<1>(Xt);
                    f32x16 Xn = MFMA32(xt0, x0, zero16()); Xn = MFMA32(xt1, x1, Xn);
                    if (lvl < 3) { f32x16 Xtn = MFMA32(x0, xt0, zero16()); Xtn = MFMA32(x1, xt1, Xtn); Xt = Xtn; }
                    X = Xn;
                    const bf16x8 n0 = pack8<0>(X), n1 = pack8<1>(X), p0 = pack8<0>(Pt), p1 = pack8<1>(Pt);
                    Pt = MFMA32(n0, p0, Pt); Pt = MFMA32(n1, p1, Pt);
                }
                { float Ga[16], Ba[16]; int z1 = 0; LAUNDER(z1); rowvals16(GS, hh, z1, Ga); rowvals16(BS, hh, z1, Ba);
                  f32x16 T1, T2;
#pragma unroll
                  for (int reg = 0; reg < 16; ++reg) { T2[reg] = Pt[reg] * Ba[reg]; T1[reg] = -T2[reg] * __expf(Ga[reg]); }
                  *(LAS bf16x8*)(TF + 0 * 1024 + lane * 16) = pack8<0>(T1); *(LAS bf16x8*)(TF + 1 * 1024 + lane * 16) = pack8<1>(T1);
                  *(LAS bf16x8*)(TF + 2 * 1024 + lane * 16) = pack8<0>(T2); *(LAS bf16x8*)(TF + 3 * 1024 + lane * 16) = pack8<1>(T2); }
            }
            SCHED_FENCE();
            float Ga[16]; { int z2 = 0; LAUNDER(z2); rowvals16(GS, hh, z2, Ga); }
            f32x16 at = zero16();
            int l1 = lane; LAUNDER(l1);
#pragma unroll
            for (int ks = 0; ks < 4; ++ks) at = MFMA32(rowfrag_nat(KN, ks, l1), rowfrag_nat(QN, ks, l1), at);
            SCHED_FENCE();
#pragma unroll
            for (int ks = 4; ks < 8; ++ks) at = MFMA32(rowfrag_nat(KN, ks, l1), rowfrag_nat(QN, ks, l1), at);
#pragma unroll
            for (int reg = 0; reg < 16; ++reg) at[reg] = (crow(reg, hh) <= r) ? at[reg] * __expf(Gc - Ga[reg]) : 0.f;
            at0 = pack8<0>(at); at1 = pack8<1>(at);
            SCHED_FENCE();
            o = zero16();
            int l2 = lane; LAUNDER(l2);
#pragma unroll
            for (int dt = 0; dt < 2; ++dt) { o = MFMA32(rowfrag_perm(QN, 2 * dt, l2), pack8<0>(S[dt]), o); o = MFMA32(rowfrag_perm(QN, 2 * dt + 1, l2), pack8<1>(S[dt]), o); }
            SCHED_FENCE();
#pragma unroll
            for (int dt = 2; dt < 4; ++dt) { o = MFMA32(rowfrag_perm(QN, 2 * dt, l2), pack8<0>(S[dt]), o); o = MFMA32(rowfrag_perm(QN, 2 * dt + 1, l2), pack8<1>(S[dt]), o); }
#pragma unroll
            for (int reg = 0; reg < 16; ++reg) o[reg] *= __expf(Ga[reg]);
        }
        __syncthreads();
        u32x4 prev[2]; load_prev(ochunk, o_loff, n >= 32, prev);
        if (n + 1 < 64) { dma(n + 1, (n + 1) & 1); issue_g(n + 1); }
        {
            const bf16x8 tf0 = *(const LAS bf16x8*)(TF + 0 * 1024 + lane * 16), tf1 = *(const LAS bf16x8*)(TF + 1 * 1024 + lane * 16);
            const bf16x8 tf2 = *(const LAS bf16x8*)(TF + 2 * 1024 + lane * 16), tf3 = *(const LAS bf16x8*)(TF + 3 * 1024 + lane * 16);
            int l3 = lane; LAUNDER(l3);
            const bf16x8 vt0 = trfrag_perm(VV, ct, 0, l3), vt1 = trfrag_perm(VV, ct, 1, l3);
            f32x16 vn = MFMA32(tf2, vt0, zero16()); vn = MFMA32(tf3, vt1, vn);
#pragma unroll
            for (int dt = 0; dt < 4; ++dt) {
                f32x16 w = MFMA32(trfrag_perm(KN, dt, 0, l3), tf0, zero16()); w = MFMA32(trfrag_perm(KN, dt, 1, l3), tf1, w);
                vn = MFMA32(pack8<0>(w), pack8<0>(S[dt]), vn); vn = MFMA32(pack8<1>(w), pack8<1>(S[dt]), vn);
            }
            o = MFMA32(at0, pack8<0>(vn), o); o = MFMA32(at1, pack8<1>(vn), o);
            SCHED_FENCE();
            const float Glast = GS[31]; const float decl = __expf(Glast);
#pragma unroll
            for (int g = 0; g < 4; ++g) { const f32x4 gv = *(const LAS f32x4*)(GS + 8 * g + 4 * hh);
#pragma unroll
                for (int e = 0; e < 4; ++e) vn[4 * g + e] *= __expf(Glast - gv[e]); }
            const bf16x8 vn0 = pack8<0>(vn), vn1 = pack8<1>(vn);
            int l4 = lane; LAUNDER(l4);
#pragma unroll
            for (int dt = 0; dt < 4; ++dt) { f32x16 ds = S[dt];
#pragma unroll
                for (int reg = 0; reg < 16; ++reg) ds[reg] *= decl;
                ds = MFMA32(trfrag_perm(KN, dt, 0, l4), vn0, ds); ds = MFMA32(trfrag_perm(KN, dt, 1, l4), vn1, ds); S[dt] = ds; }
        }
        SCHED_FENCE();
        store_o(ochunk, o_loff, o, lane, scr, prev);
        if (n + 1 < 64) commit_g((n + 1) & 1);
        __syncthreads();
    }
}

__device__ __forceinline__ void p2c_headnorm(const Params& p, int wv) {
    const int tid = TID(wv), lane = tid & 63, wave = wv;
    const int gw = blockIdx.x * NWAVES + wave, NGW = gridDim.x * NWAVES;
    bf16_t* oa = (bf16_t*)p.out; bf16_t* ob = oa + (size_t)NTOK * D;
    for (int m = gw; m < NTOK; m += NGW) {
#pragma unroll
        for (int hd = 0; hd < 4; ++hd) { u32x2* op = (u32x2*)(oa + (size_t)m * D + hd * 256) + lane; const u32x2 w = *op;
            const float v0 = bflo(w.x), v1 = bfhi(w.x), v2 = bflo(w.y), v3 = bfhi(w.y);
            const float rstd = rsqrtf(wave_sum((v0 * v0 + v1 * v1) + (v2 * v2 + v3 * v3)) * (1.f / 256.f) + EPS);
            const f32x4 g = *(const f32x4*)(p.gla_norm_w + lane * 4);
            u32x2 o; o.x = pk2(v0 * rstd * g.x, v1 * rstd * g.y); o.y = pk2(v2 * rstd * g.z, v3 * rstd * g.w); *op = o; }
#pragma unroll
        for (int hd = 0; hd < 8; ++hd) { unsigned* op = (unsigned*)(ob + (size_t)m * D + hd * 128) + lane; const unsigned w = *op;
            const float v0 = bflo(w), v1 = bfhi(w);
            const float rstd = rsqrtf(wave_sum(v0 * v0 + v1 * v1) * (1.f / 128.f) + EPS);
            const f32x2 g = *(const f32x2*)(p.gdn_norm_w + lane * 2);
            *op = pk2(v0 * rstd * g.x, v1 * rstd * g.y); }
    }
}

__device__ __forceinline__ void p2_gla_item(const Params& p, int b, int h, LAS float* sm, int wv) {
    const int tid = TID(wv), j = tid & 255, pp = tid >> 8, lane = tid & 63, wave = wv;
    LAS float* s_q = sm; LAS float* s_k = sm + 128; LAS float* s_a = sm + 256; LAS float* s_glr = sm + 384; LAS float* s_b = sm + 400; LAS float* s_w2 = sm + 528; LAS float* s_op = sm + 528 + 2048;
    const bf16_t* proj = (const bf16_t*)(p.ws + OFF_PROJ); bf16_t* og = (bf16_t*)p.out;
    for (int dir = 0; dir < 2; ++dir) {
        const float* w2 = dir ? p.gla_w2_b : p.gla_w2_f; const float* bb = dir ? p.gla_b_b : p.gla_b_f;
        __syncthreads();
        for (int i = tid; i < 2048; i += NTHR) { const int r = i >> 7, d = i & 127; s_w2[i] = w2[r * 512 + h * 128 + d]; }
        if (tid < 128) s_b[tid] = bb[h * 128 + tid];
        float S[64];
#pragma unroll
        for (int i = 0; i < 64; ++i) S[i] = 0.f;
        unsigned short nq = 0, nk = 0, ng = 0, nv = 0;
        { const bf16_t* rp = proj + (size_t)(b * SEQ + (dir ? SEQ - 1 : 0)) * N1;
          if (tid < 128) { nq = rp[C_GQ + h * 128 + tid]; nk = rp[C_GK + h * 128 + tid]; } else if (tid < 144) ng = rp[C_GLR + dir * 16 + tid - 128];
          nv = rp[C_GV + h * 256 + j]; }
        for (int step = 0; step < SEQ; ++step) {
            const int t = dir ? SEQ - 1 - step : step; const size_t row = (size_t)b * SEQ + t;
            if (tid < 128) { s_q[tid] = bf2f(nq) * 0.08838834764831845f; s_k[tid] = bf2f(nk); } else if (tid < 144) s_glr[tid - 128] = bf2f(ng);
            const float v = bf2f(nv);
            if (step + 1 < SEQ) { const bf16_t* rp = proj + (size_t)(b * SEQ + (dir ? t - 1 : t + 1)) * N1;
                if (tid < 128) { nq = rp[C_GQ + h * 128 + tid]; nk = rp[C_GK + h * 128 + tid]; } else if (tid < 144) ng = rp[C_GLR + dir * 16 + tid - 128];
                nv = rp[C_GV + h * 256 + j]; }
            __syncthreads();
            if (tid < 128) { float z = s_b[tid];
#pragma unroll
                for (int r = 0; r < 16; ++r) z += s_glr[r] * s_w2[r * 128 + tid];
                s_a[tid] = expf(log_sigmoid_f(z) * (1.f / 16.f)); }
            __syncthreads();
            float o = 0.f;
#pragma unroll
            for (int dd = 0; dd < 64; ++dd) { const int d = 64 * pp + dd; S[dd] = s_a[d] * S[dd] + s_k[d] * v; o += s_q[d] * S[dd]; }
            s_op[pp * 256 + j] = o;
            __syncthreads();
            if (pp == 0) { float ot = s_op[j] + s_op[256 + j]; bf16_t* op = og + row * D + h * 256 + j; if (dir) ot += bf2f(*op); *op = (bf16_t)f2bf(ot); }
        }
    }
}

__device__ __forceinline__ void p2_gdn_item(const Params& p, int b, int h, LAS float* sm, int wv) {
    const int tid = TID(wv), j = tid & 127, pp = tid >> 7;
    LAS float* s_c = sm;
    LAS float* s_sc = sm + 384;
    LAS float* s_p1 = sm + 392;
    LAS float* s_p2 = sm + 392 + 512;
    const bf16_t* proj = (const bf16_t*)(p.ws + OFF_PROJ); bf16_t* og = (bf16_t*)p.out + (size_t)NTOK * D;
    const int col = C_DQ + (tid >> 7) * 1024 + h * 128 + (tid & 127);
    for (int dir = 0; dir < 2; ++dir) {
        const float* gtab = (const float*)(p.ws + OFF_GT) + (((size_t)dir * NB + b) * 8 + h) * SEQ; const float* btab = (const float*)(p.ws + OFF_BT) + (((size_t)dir * NB + b) * 8 + h) * SEQ;
        float S[32];
#pragma unroll
        for (int i = 0; i < 32; ++i) S[i] = 0.f;
        __syncthreads();
        for (int step = 0; step < SEQ; ++step) {
            const int t = dir ? SEQ - 1 - step : step; const size_t row = (size_t)b * SEQ + t;
            if (tid < 384) s_c[tid] = bf2f(proj[row * N1 + col]);
            else if (tid == 384) { const float g = gtab[t]; const float gp = (step & 31) ? gtab[dir ? t + 1 : t - 1] : 0.f; s_sc[0] = expf(g - gp); s_sc[1] = btab[t]; }
            __syncthreads();
            const float alpha = s_sc[0], beta = s_sc[1];
            float pred = 0.f;
#pragma unroll
            for (int dd = 0; dd < 32; ++dd) { const int d = 32 * pp + dd; S[dd] *= alpha; pred += s_c[128 + d] * S[dd]; }
            s_p1[pp * 128 + j] = pred;
            __syncthreads();
            const float predt = (s_p1[j] + s_p1[128 + j]) + (s_p1[256 + j] + s_p1[384 + j]);
            const float delta = beta * (s_c[256 + j] - predt);
            float o = 0.f;
#pragma unroll
            for (int dd = 0; dd < 32; ++dd) { const int d = 32 * pp + dd; S[dd] += s_c[128 + d] * delta; o += s_c[d] * S[dd]; }
            s_p2[pp * 128 + j] = o;
            __syncthreads();
            if (pp == 0) { float ot = (s_p2[j] + s_p2[128 + j]) + (s_p2[256 + j] + s_p2[384 + j]); bf16_t* op = og + row * D + h * 128 + j; if (dir) ot += bf2f(*op); *op = (bf16_t)f2bf(ot); }
        }
    }
}

#ifndef SCAN_GLA_CHUNKED
#define SCAN_GLA_CHUNKED 1
#endif
#ifndef SCAN_GDN_CHUNKED
#define SCAN_GDN_CHUNKED 1
#endif
__device__ __forceinline__ void p2_scans(const Params& p, LAS unsigned char* lds, int wv) {
    LAS float* sm = (LAS float*)lds;
    constexpr int NGLA = SCAN_GLA_CHUNKED ? 64 : 32;
    for (int it = blockIdx.x; it < NGLA + 64; it += gridDim.x) {
        __syncthreads();
        if (it < NGLA) { if constexpr (SCAN_GLA_CHUNKED) p2_gla_chunked(p, it >> 3, (it >> 1) & 3, it & 1, lds, wv); else p2_gla_item(p, it >> 2, it & 3, sm, wv); }
        else { const int q = it - NGLA; if constexpr (SCAN_GDN_CHUNKED) p2_gdn_chunked(p, q >> 3, q & 7, lds, wv); else p2_gdn_item(p, q >> 3, q & 7, sm, wv); }
    }
}

__device__ __forceinline__ void p5_router(const Params& p, LAS unsigned char* lds, int wv) {
    const int tid = TID(wv), lane = tid & 63, wave = wv;
    const int gw = blockIdx.x * NWAVES + wave, NGW = gridDim.x * NWAVES;
    { LAS float* scr = (LAS float*)(lds + wave * 8448);
      bf16_t* wgu = (bf16_t*)(p.ws + OFF_WGU); bf16_t* wd = (bf16_t*)(p.ws + OFF_WD);
      for (int it = gw; it < NEXP * 384; it += NGW) {
          const int e = it / 384, r = it % 384;
          if (r < 128) { const int kb = r >> 3, nb = r & 7; transpose_item(p.w_gate + (size_t)e * D * DEXP, DEXP, kb * 64, nb * 32, p.norm2_w, scr, lane, GuRow{wgu + (size_t)e * 512 * D, 0}); }
          else if (r < 256) { const int q = r - 128, kb = q >> 3, nb = q & 7; transpose_item(p.w_up + (size_t)e * D * DEXP, DEXP, kb * 64, nb * 32, p.norm2_w, scr, lane, GuRow{wgu + (size_t)e * 512 * D, 1}); }
          else { const int q = r - 256, kb = q >> 5, nb = q & 31; transpose_item(p.w_down + (size_t)e * DEXP * D, D, kb * 64, nb * 32, nullptr, scr, lane, PlainRow{wd + (size_t)e * D * DEXP, DEXP}); }
      } }
    __syncthreads();
    LAS float* part = (LAS float*)lds;
    LAS float* s_rstd = part + 8 * 64 * 37;
    const float* x1 = (const float*)(p.ws + OFF_X1); bf16_t* h2 = (bf16_t*)(p.ws + OFF_MIX);
    unsigned* cnt = (unsigned*)(p.ws + OFF_CTL); int* lslot = (int*)(p.ws + OFF_LSLOT); float* lw = (float*)(p.ws + OFF_LW);
    const float* __restrict__ nw2 = p.norm2_w; const float* __restrict__ wg = p.w_group; const float* __restrict__ wrt = p.w_router;
    for (int blk = blockIdx.x; blk < NTOK / 64; blk += gridDim.x) {
        const int tok = blk * 64 + lane;
        float acc[36]; float ss = 0.f;
#pragma unroll
        for (int i = 0; i < 36; ++i) acc[i] = 0.f;
        const float* xr = x1 + (size_t)tok * D + wave * 128;
#pragma unroll 1
        for (int kk = 0; kk < 128; kk += 4) {
            const f32x4 xv = *(const f32x4*)(xr + kk); const int k = wave * 128 + kk;
            ss += (xv.x * xv.x + xv.y * xv.y) + (xv.z * xv.z + xv.w * xv.w);
#pragma unroll
            for (int i = 0; i < 4; ++i) { const float xs = xv[i] * nw2[k + i];
#pragma unroll
                for (int jj = 0; jj < 4; ++jj) acc[jj] += xs * wg[(k + i) * 4 + jj];
#pragma unroll
                for (int jj = 0; jj < 32; ++jj) acc[4 + jj] += xs * wrt[(k + i) * 32 + jj]; }
        }
#pragma unroll
        for (int i = 0; i < 36; ++i) part[(wave * 64 + lane) * 37 + i] = acc[i];
        part[(wave * 64 + lane) * 37 + 36] = ss;
        __syncthreads();
        if (wave == 0) {
            float l[36]; float st = 0.f;
#pragma unroll
            for (int i = 0; i < 36; ++i) l[i] = 0.f;
#pragma unroll 1
            for (int w = 0; w < 8; ++w) {
#pragma unroll
                for (int i = 0; i < 36; ++i) l[i] += part[(w * 64 + lane) * 37 + i];
                st += part[(w * 64 + lane) * 37 + 36]; }
            const float rstd = rsqrtf(st * (1.f / D) + EPS);
            s_rstd[lane] = rstd;
#pragma unroll
            for (int i = 0; i < 36; ++i) l[i] *= rstd;
            int gi = 0; float gm = l[0];
#pragma unroll
            for (int i = 1; i < 4; ++i) if (l[i] > gm) { gm = l[i]; gi = i; }
            float gs = 0.f;
#pragma unroll
            for (int i = 0; i < 4; ++i) gs += expf(l[i] - gm);
            const float group_w = 1.f / gs;
            float el[8];
#pragma unroll
            for (int i = 0; i < 8; ++i) el[i] = gi == 0 ? l[4 + i] : gi == 1 ? l[12 + i] : gi == 2 ? l[20 + i] : l[28 + i];
            int i1 = 0; float m1 = el[0];
#pragma unroll
            for (int i = 1; i < 8; ++i) if (el[i] > m1) { m1 = el[i]; i1 = i; }
            int i2 = -1; float m2 = -3.0e38f;
#pragma unroll
            for (int i = 0; i < 8; ++i) if (i != i1 && el[i] > m2) { m2 = el[i]; i2 = i; }
            const float e2 = expf(m2 - m1);
            const float w1 = group_w / (1.f + e2), w2 = group_w * e2 / (1.f + e2);
            const int ea = gi * 8 + i1, eb = gi * 8 + i2;
            const unsigned pa = atomicAdd(&cnt[ea], 1u); lslot[ea * LISTCAP + pa] = tok * 2; lw[ea * LISTCAP + pa] = w1;
            const unsigned pb = atomicAdd(&cnt[eb], 1u); lslot[eb * LISTCAP + pb] = tok * 2 + 1; lw[eb * LISTCAP + pb] = w2;
        }
        __syncthreads();
#pragma unroll
        for (int r = 0; r < 8; ++r) {
            const int row = blk * 64 + wave * 8 + r; const float rs = s_rstd[wave * 8 + r];
            const f32x4* xq = (const f32x4*)(x1 + (size_t)row * D) + lane; u32x2* o8 = (u32x2*)(h2 + (size_t)row * D) + lane;
#pragma unroll
            for (int jj = 0; jj < 4; ++jj) { const f32x4 v = xq[64 * jj]; u32x2 w; w.x = pk2(v.x * rs, v.y * rs); w.y = pk2(v.z * rs, v.w * rs); o8[64 * jj] = w; }
        }
        __syncthreads();
    }
}

__device__ __forceinline__ void moe_tables(const Params& p, LAS int* tab, int per_rb, int wv) {
    const unsigned* cnt = (const unsigned*)(p.ws + OFF_CTL);
    if (TID(wv) == 0) { int hr = 0, pre = 0;
        for (int e = 0; e < NEXP; ++e) { const int c = (int)cnt[e]; tab[e] = c; tab[32 + e] = hr; tab[64 + e] = pre; hr += ((c + 255) >> 8) << 8; pre += ((c + 63) >> 6) * per_rb; }
        tab[64 + 32] = pre; }
    __syncthreads();
}
__device__ __forceinline__ void p6_expert_up(const Params& p, LAS unsigned char* lds, int wv) {
    LAS int* tab = (LAS int*)lds; moe_tables(p, tab, 8, wv);
    const int tid = TID(wv), lane = tid & 63, wave = wv, fr = lane & 15, fq = lane >> 4;
    const int gw = blockIdx.x * NWAVES + wave, NGW = gridDim.x * NWAVES, total = tab[96];
    const bf16_t* h2 = (const bf16_t*)(p.ws + OFF_MIX); const bf16_t* wgu = (const bf16_t*)(p.ws + OFF_WGU); bf16_t* hid = (bf16_t*)(p.ws + OFF_HID);
    const int* lslot = (const int*)(p.ws + OFF_LSLOT);
    for (int it = gw; it < total; it += NGW) {
        int e = 0;
#pragma unroll 1
        for (int q = 1; q < NEXP; ++q) if (it >= tab[64 + q]) e = q;
        const int r = it - tab[64 + e], rb = r >> 3, hb = r & 7, c = tab[e];
        const bf16_t* ap[4];
#pragma unroll
        for (int mi = 0; mi < 4; ++mi) { const int a = rb * 64 + 16 * mi + fr; const int tok = a < c ? (lslot[e * LISTCAP + a] >> 1) : 0; ap[mi] = h2 + (size_t)tok * D + 8 * fq; }
        const bf16_t* bp[2][2];
#pragma unroll
        for (int ni = 0; ni < 2; ++ni) { const int n = hb * 32 + 16 * ni + fr; const int prow = 8 * (n >> 2) + (n & 3); bp[0][ni] = wgu + ((size_t)e * 512 + prow) * D + 8 * fq; bp[1][ni] = bp[0][ni] + 4 * D; }
        f32x4 ag[4][2], au[4][2];
#pragma unroll
        for (int mi = 0; mi < 4; ++mi)
#pragma unroll
            for (int ni = 0; ni < 2; ++ni) { ag[mi][ni] = (f32x4){0.f, 0.f, 0.f, 0.f}; au[mi][ni] = (f32x4){0.f, 0.f, 0.f, 0.f}; }
        for (int k0 = 0; k0 < D; k0 += 32) {
            bf16x8 a[4], bg[2], bu[2];
#pragma unroll
            for (int mi = 0; mi < 4; ++mi) a[mi] = *(const bf16x8*)(ap[mi] + k0);
#pragma unroll
            for (int ni = 0; ni < 2; ++ni) { bg[ni] = *(const bf16x8*)(bp[0][ni] + k0); bu[ni] = *(const bf16x8*)(bp[1][ni] + k0); }
#pragma unroll
            for (int mi = 0; mi < 4; ++mi)
#pragma unroll
                for (int ni = 0; ni < 2; ++ni) { ag[mi][ni] = __builtin_amdgcn_mfma_f32_16x16x32_bf16(a[mi], bg[ni], ag[mi][ni], 0, 0, 0); au[mi][ni] = __builtin_amdgcn_mfma_f32_16x16x32_bf16(a[mi], bu[ni], au[mi][ni], 0, 0, 0); }
        }
        const int hr0 = tab[32 + e] + rb * 64;
#pragma unroll
        for (int mi = 0; mi < 4; ++mi)
#pragma unroll
            for (int ni = 0; ni < 2; ++ni)
#pragma unroll
                for (int q = 0; q < 4; ++q) { const int row = hr0 + 16 * mi + 4 * fq + q, colh = hb * 32 + 16 * ni + fr;
                    hid[(size_t)row * DEXP + colh] = (bf16_t)f2bf(silu_f(ag[mi][ni][q]) * au[mi][ni][q]); }
    }
}
__device__ __forceinline__ void p7_expert_down(const Params& p, LAS unsigned char* lds, int wv) {
    LAS int* tab = (LAS int*)lds; moe_tables(p, tab, 16, wv);
    const int tid = TID(wv), lane = tid & 63, wave = wv, fr = lane & 15, fq = lane >> 4;
    const int gw = blockIdx.x * NWAVES + wave, NGW = gridDim.x * NWAVES, total = tab[96];
    const bf16_t* hid = (const bf16_t*)(p.ws + OFF_HID); const bf16_t* wd = (const bf16_t*)(p.ws + OFF_WD); bf16_t* yb = (bf16_t*)(p.ws + OFF_YB);
    const int* lslot = (const int*)(p.ws + OFF_LSLOT); const float* lw = (const float*)(p.ws + OFF_LW);
    for (int it = gw; it < total; it += NGW) {
        int e = 0;
#pragma unroll 1
        for (int q = 1; q < NEXP; ++q) if (it >= tab[64 + q]) e = q;
        const int r = it - tab[64 + e], rb = r >> 4, cb = r & 15, c = tab[e];
        const int hr0 = tab[32 + e] + rb * 64;
        const bf16_t* ap[4]; const bf16_t* bp[4];
#pragma unroll
        for (int mi = 0; mi < 4; ++mi) ap[mi] = hid + (size_t)(hr0 + 16 * mi + fr) * DEXP + 8 * fq;
#pragma unroll
        for (int ni = 0; ni < 4; ++ni) bp[ni] = wd + ((size_t)e * D + cb * 64 + 16 * ni + fr) * DEXP + 8 * fq;
        f32x4 acc[4][4];
#pragma unroll
        for (int mi = 0; mi < 4; ++mi)
#pragma unroll
            for (int ni = 0; ni < 4; ++ni) acc[mi][ni] = (f32x4){0.f, 0.f, 0.f, 0.f};
        for (int k0 = 0; k0 < DEXP; k0 += 32) {
            bf16x8 a[4], bb[4];
#pragma unroll
            for (int mi = 0; mi < 4; ++mi) a[mi] = *(const bf16x8*)(ap[mi] + k0);
#pragma unroll
            for (int ni = 0; ni < 4; ++ni) bb[ni] = *(const bf16x8*)(bp[ni] + k0);
#pragma unroll
            for (int mi = 0; mi < 4; ++mi)
#pragma unroll
                for (int ni = 0; ni < 4; ++ni) acc[mi][ni] = __builtin_amdgcn_mfma_f32_16x16x32_bf16(a[mi], bb[ni], acc[mi][ni], 0, 0, 0);
        }
#pragma unroll
        for (int mi = 0; mi < 4; ++mi)
#pragma unroll
            for (int q = 0; q < 4; ++q) { const int a = rb * 64 + 16 * mi + 4 * fq + q;
                if (a < c) { const int slot = lslot[e * LISTCAP + a]; const float w = lw[e * LISTCAP + a];
#pragma unroll
                    for (int ni = 0; ni < 4; ++ni) yb[(size_t)slot * D + cb * 64 + 16 * ni + fr] = (bf16_t)f2bf(acc[mi][ni][q] * w); } }
    }
}

__device__ __forceinline__ void p8_final(const Params& p, int wv) {
    const int tid = TID(wv), lane = tid & 63, wave = wv;
    const int gw = blockIdx.x * NWAVES + wave, NGW = gridDim.x * NWAVES;
    const float* x1 = (const float*)(p.ws + OFF_X1); const bf16_t* yb = (const bf16_t*)(p.ws + OFF_YB);
    for (int m = gw; m < NTOK; m += NGW) {
        const f32x4* xr = (const f32x4*)(x1 + (size_t)m * D) + lane;
        const u32x2* y0 = (const u32x2*)(yb + (size_t)(2 * m) * D) + lane; const u32x2* y1 = (const u32x2*)(yb + (size_t)(2 * m + 1) * D) + lane;
        f32x4 v[4]; float s = 0.f;
#pragma unroll
        for (int j = 0; j < 4; ++j) { v[j] = xr[64 * j]; const u32x2 a = y0[64 * j], b = y1[64 * j];
            v[j].x += bflo(a.x) + bflo(b.x); v[j].y += bfhi(a.x) + bfhi(b.x); v[j].z += bflo(a.y) + bflo(b.y); v[j].w += bfhi(a.y) + bfhi(b.y);
            s += (v[j].x * v[j].x + v[j].y * v[j].y) + (v[j].z * v[j].z + v[j].w * v[j].w); }
        const float rstd = rsqrtf(wave_sum(s) * (1.f / D) + EPS);
        f32x4* o = (f32x4*)(p.out + (size_t)m * D) + lane;
#pragma unroll
        for (int j = 0; j < 4; ++j) { const f32x4 g = *((const f32x4*)p.norm_f_w + lane + 64 * j); o[64 * j] = (f32x4){v[j].x * rstd * g.x, v[j].y * rstd * g.y, v[j].z * rstd * g.z, v[j].w * rstd * g.w}; }
    }
}


#define XB_TMO      128
#define XB_XCNT(j)  (256  + 64 * (j))
#define XB_XSUB(j)  (1280 + 64 * (j))
#define XB_XGEN(j)  (2304 + 64 * (j))
#define XB_TOP      3328
#define XB_TOPGEN   3392
#define XCD_BAR_WORDS 3456
#define XB_SPIN_CAP (1u << 22)
__device__ __forceinline__ unsigned xb_ld(unsigned* p)              { return __hip_atomic_load(p, __ATOMIC_RELAXED, __HIP_MEMORY_SCOPE_AGENT); }
__device__ __forceinline__ unsigned xb_add(unsigned* p, unsigned v) { return __hip_atomic_fetch_add(p, v, __ATOMIC_RELAXED, __HIP_MEMORY_SCOPE_AGENT); }
__device__ __forceinline__ unsigned xb_xcc_id() { return (unsigned)__builtin_amdgcn_s_getreg((3 << 11) | 20) & 0xFu; }
#define XB_SPIN(cond, bar) do { unsigned _sp = 0; while (cond) { __builtin_amdgcn_s_sleep(1); \
    if ((++_sp & 255u) == 0u) { if (xb_ld(&(bar)[XB_TMO])) break; if (_sp > XB_SPIN_CAP) { atomicAdd(&(bar)[XB_TMO], 1u); break; } } } } while (0)
struct XcdBarrier { unsigned* bar; unsigned x; volatile LAS unsigned* st; };
__device__ __forceinline__ XcdBarrier xcd_barrier_post(unsigned* bar, volatile LAS unsigned* st, bool leader) {
    XcdBarrier b; b.bar = bar; b.x = xb_xcc_id(); b.st = st;
    if (leader) (void)xb_add(&bar[XB_XCNT(b.x)], 1u);
    return b;
}
__device__ __forceinline__ void xcd_barrier_complete(unsigned* bar, unsigned x, unsigned& nloc, unsigned& nx) {
    const unsigned G = gridDim.x * gridDim.y * gridDim.z;
    unsigned sum, cnt, mine, sp = 0u;
    for (;;) {
        sum = 0u; cnt = 0u; mine = 0u;
#pragma unroll
        for (unsigned j = 0; j < 16; ++j) { const unsigned c = xb_ld(&bar[XB_XCNT(j)]); sum += c; cnt += (c > 0u) ? 1u : 0u; mine = (j == x) ? c : mine; }
        if (sum == G) break;
        __builtin_amdgcn_s_sleep(1);
        if ((++sp & 255u) == 0u) { if (xb_ld(&bar[XB_TMO])) break; if (sp > XB_SPIN_CAP) { atomicAdd(&bar[XB_TMO], 1u); break; } }
    }
    nloc = mine > 0u ? mine : 1u; nx = cnt > 0u ? cnt : 1u;
}
__device__ __forceinline__ void xcd_barrier(const XcdBarrier& b, bool leader) {
    asm volatile("s_waitcnt vmcnt(0)" ::: "memory");
    __syncthreads();
    if (leader) {
        unsigned* bar = b.bar;
        __builtin_amdgcn_s_waitcnt(0);
        unsigned nloc = b.st[0], nx = b.st[1];
        if (nloc == 0u) { xcd_barrier_complete(bar, b.x, nloc, nx); b.st[0] = nloc; b.st[1] = nx; }
        const unsigned old = xb_add(&bar[XB_XSUB(b.x)], 1u);
        const unsigned gen = old / nloc;
        if (old + 1u == (gen + 1u) * nloc) {
            __builtin_amdgcn_fence(__ATOMIC_RELEASE, "agent");
            asm volatile("s_waitcnt vmcnt(0)" ::: "memory");
            const unsigned og = xb_add(&bar[XB_TOP], 1u);
            const unsigned tg = og / nx;
            if (og + 1u == (tg + 1u) * nx) xb_add(&bar[XB_TOPGEN], 1u);
            else XB_SPIN(xb_ld(&bar[XB_TOPGEN]) == tg, bar);
            __builtin_amdgcn_fence(__ATOMIC_ACQUIRE, "agent");
            xb_add(&bar[XB_XGEN(b.x)], 1u);
            asm volatile("s_waitcnt vmcnt(0)" ::: "memory");
        } else {
            XB_SPIN(xb_ld(&bar[XB_XGEN(b.x)]) == gen, bar);
            __builtin_amdgcn_fence(__ATOMIC_ACQUIRE, "agent");
            asm volatile("s_waitcnt vmcnt(0)" ::: "memory");
        }
    }
    __syncthreads();
}
constexpr size_t CTL_BAR = 4096;

constexpr int NPHASES = 9;
#ifndef ONLY_PHASE
#define ONLY_PHASE -1
#endif
#define PH_ON(k) (ONLY_PHASE < 0 || ONLY_PHASE == (k))
__global__ void __launch_bounds__(NTHR, 2) fwd_megakernel(Params p) {
    extern __shared__ __attribute__((aligned(16))) unsigned char lds_raw[];
    LAS unsigned char* lds = (LAS unsigned char*)lds_raw;
    const int G = gridDim.x;
    const int wv = __builtin_amdgcn_readfirstlane((int)threadIdx.x >> 6);
    const bool leader = threadIdx.x == 0;
    volatile LAS unsigned* xst = (volatile LAS unsigned*)(lds + LDS_BYTES - 16);
    if (leader) { xst[0] = 0u; xst[1] = 0u; }
    __syncthreads();
    const XcdBarrier xbar = xcd_barrier_post((unsigned*)(p.ws + OFF_CTL + CTL_BAR), xst, leader);
#define GRID_SYNC() xcd_barrier(xbar, TID(wv) == 0)
    const int lo = p.ph_lo, hi = p.ph_hi;
#define IN(k) (PH_ON(k) && lo <= (k) && (k) < hi)
#define SEAM(k) do { if ((k) + 1 < hi && lo <= (k)) GRID_SYNC(); } while (0)
    if (IN(0)) p0_prologue(p, lds, wv);
    SEAM(0);
    if (IN(1)) { pg8::Gemm g{(const bf16_t*)(p.ws + OFF_XN), (const bf16_t*)(p.ws + OFF_WT1), NTOK, N1, D}; pg8::StaticOrder S; S.init(NTOK, N1, G, (int)blockIdx.x);
                 pg8::EpiBf16 E{(bf16_t*)(p.ws + OFF_PROJ), N1}; pg8::gemm_phase(lds, g, S, E, wv); }
    if (IN(1)) { GRID_SYNC(); p1b_prepass(p, wv); }
    SEAM(1);
    if (IN(2)) p2_scans(p, lds, wv);
    if (IN(2)) { GRID_SYNC(); p2c_headnorm(p, wv); }
    SEAM(2);
    if (IN(3)) { pg8::Gemm g{(const bf16_t*)(p.ws + OFF_XN), (const bf16_t*)(p.ws + OFF_WT3), NTOK, 4096, D}; pg8::StaticOrder S; S.init(NTOK, 4096, G, (int)blockIdx.x);
                 pg8::EpiMix E{(const bf16_t*)p.out, (const bf16_t*)p.out + (size_t)NTOK * D, (bf16_t*)(p.ws + OFF_MIX)}; pg8::gemm_phase(lds, g, S, E, wv); }
    SEAM(3);
    if (IN(4)) { pg8::Gemm g{(const bf16_t*)(p.ws + OFF_MIX), (const bf16_t*)(p.ws + OFF_WTO), NTOK, D, D}; pg8::StaticOrder S; S.init(NTOK, D, G, (int)blockIdx.x);
                 pg8::EpiRes E{p.x, (float*)(p.ws + OFF_X1), D}; pg8::gemm_phase(lds, g, S, E, wv); }
    SEAM(4);
    if (IN(5)) p5_router(p, lds, wv);
    SEAM(5);
    if (IN(6)) p6_expert_up(p, lds, wv);
    SEAM(6);
    if (IN(7)) p7_expert_down(p, lds, wv);
    SEAM(7);
    if (IN(8)) p8_final(p, wv);
#undef IN
#undef SEAM
#undef GRID_SYNC
}

extern "C" void kernel_launch(void* const* d_in, const int* in_sizes, int n_in, void* d_out, int out_size, void* d_ws, size_t ws_size, hipStream_t stream) {
    static int grid_blocks = 0;
    if (grid_blocks == 0) {
        if (n_in != 22 || in_sizes[0] != NTOK * D || out_size != NTOK * D || ws_size < WS_NEED) {
            fprintf(stderr, "kernel_launch: unexpected shapes (n_in %d, in0 %d, out %d, ws %zu, need %zu); nothing launched\n", n_in, n_in > 0 ? in_sizes[0] : -1, out_size, ws_size, (size_t)WS_NEED);
            grid_blocks = -1; return; }
        int dev = 0, cus = 0, per_cu = 0;
        hipGetDevice(&dev);
        hipDeviceGetAttribute(&cus, hipDeviceAttributeMultiprocessorCount, dev);
        if (hipFuncSetAttribute((const void*)fwd_megakernel, hipFuncAttributeMaxDynamicSharedMemorySize, LDS_BYTES) != hipSuccess) { fprintf(stderr, "kernel_launch: hipFuncSetAttribute failed\n"); grid_blocks = -1; return; }
        if (hipOccupancyMaxActiveBlocksPerMultiprocessor(&per_cu, (const void*)fwd_megakernel, NTHR, LDS_BYTES) != hipSuccess || per_cu < 1) { fprintf(stderr, "kernel_launch: occupancy query failed (%d)\n", per_cu); grid_blocks = -1; (void)hipGetLastError(); return; }
        if (per_cu > 1) per_cu = 1;
        grid_blocks = cus * per_cu;
    }
    if (grid_blocks < 0) return;
    hipMemsetAsync((char*)d_ws + OFF_CTL, 0, 65536, stream);
    Params p{};
    p.x = (const float*)d_in[0]; p.norm1_w = (const float*)d_in[1]; p.w_in = (const float*)d_in[2]; p.gla_w2_f = (const float*)d_in[3]; p.gla_b_f = (const float*)d_in[4];
    p.gla_w2_b = (const float*)d_in[5]; p.gla_b_b = (const float*)d_in[6]; p.gla_norm_w = (const float*)d_in[7]; p.conv_w = (const float*)d_in[8]; p.a_log_f = (const float*)d_in[9];
    p.dt_bias_f = (const float*)d_in[10]; p.a_log_b = (const float*)d_in[11]; p.dt_bias_b = (const float*)d_in[12]; p.gdn_norm_w = (const float*)d_in[13]; p.w_out = (const float*)d_in[14];
    p.norm2_w = (const float*)d_in[15]; p.w_group = (const float*)d_in[16]; p.w_router = (const float*)d_in[17]; p.w_gate = (const float*)d_in[18]; p.w_up = (const float*)d_in[19];
    p.w_down = (const float*)d_in[20]; p.norm_f_w = (const float*)d_in[21];
    p.out = (float*)d_out; p.ws = (unsigned char*)d_ws; p.ph_lo = 0; p.ph_hi = NPHASES;
    hipLaunchKernelGGL(fwd_megakernel, dim3(grid_blocks), dim3(NTHR), LDS_BYTES, stream, p);
    const hipError_t e = hipPeekAtLastError();
    if (e != hipSuccess) fprintf(stderr, "kernel_launch: launch failed: %s (grid %d)\n", hipGetErrorString(e), grid_blocks);
}
```

```cpp
#include <hip/hip_runtime.h>
#include <hip/hip_cooperative_groups.h>
#include <cstdio>
#include <cstdint>
namespace cg = cooperative_groups;

#define LAS __attribute__((address_space(3)))
typedef unsigned short bf16_t;
typedef short bf16x8 __attribute__((ext_vector_type(8)));
typedef float f32x4 __attribute__((ext_vector_type(4)));
typedef float f32x2 __attribute__((ext_vector_type(2)));
typedef unsigned u32x4 __attribute__((ext_vector_type(4)));
typedef unsigned u32x2 __attribute__((ext_vector_type(2)));

constexpr int D = 1024, NB = 8, SEQ = 2048, NTOK = NB * SEQ, DIN = 9280;
constexpr int N1 = 5376;
constexpr int C_GQ = 0, C_GK = 512, C_GV = 1024, C_DQ = 2048, C_DK = 3072, C_DV = 4096, C_GLR = 5120, C_DAB = 5152, N1_USED = 5184;
constexpr int NEXP = 32, DEXP = 256, LISTCAP = 16384, HID_ROWS = 40960;
constexpr float EPS = 1e-6f;
constexpr int LDS_BYTES = 163840;
constexpr int NTHR = 512, NWAVES = 8;

constexpr size_t OFF_CTL = 0;
constexpr size_t OFF_PROJ = 65536;
constexpr size_t SZ_PROJ = (size_t)NTOK * N1 * 2;
constexpr size_t OFF_XN = OFF_PROJ + SZ_PROJ;
constexpr size_t OFF_WT3 = OFF_XN + (size_t)NTOK * D * 2;
constexpr size_t OFF_WTO = OFF_WT3 + (size_t)4096 * D * 2;
constexpr size_t OFF_WT1 = OFF_WTO + (size_t)D * D * 2;
constexpr size_t OFF_END1 = OFF_WT1 + (size_t)N1 * D * 2;
constexpr size_t OFF_EG = OFF_WT1;
constexpr size_t OFF_DEC = OFF_EG + (size_t)2 * NTOK * 512 * 2;
constexpr size_t OFF_GT = OFF_DEC + (size_t)2 * NB * 4 * 64 * 128 * 4;
constexpr size_t OFF_BT = OFF_GT + (size_t)2 * NB * 8 * SEQ * 4;
constexpr size_t OFF_PART = OFF_BT + (size_t)2 * NB * 8 * SEQ * 4;
constexpr size_t OFF_TAB_END = OFF_PART + (size_t)NTOK * 64 * 4;
constexpr size_t OFF_X1 = OFF_PROJ;
constexpr size_t OFF_MIX = OFF_X1 + (size_t)NTOK * D * 4;
constexpr size_t OFF_WGU = OFF_MIX + (size_t)NTOK * D * 2;
constexpr size_t OFF_WD = OFF_WGU + (size_t)NEXP * 512 * D * 2;
constexpr size_t OFF_HID = OFF_WD + (size_t)NEXP * D * DEXP * 2;
constexpr size_t OFF_OVL_END = OFF_HID + (size_t)HID_ROWS * DEXP * 2;
static_assert(OFF_OVL_END <= OFF_XN, "overlay exceeds the projection region");
constexpr size_t OFF_YB = OFF_XN;
constexpr size_t OFF_LSLOT = OFF_YB + (size_t)2 * NTOK * D * 2;
constexpr size_t OFF_LW = OFF_LSLOT + (size_t)NEXP * LISTCAP * 4;
constexpr size_t WS_NEED = (OFF_LW + (size_t)NEXP * LISTCAP * 4) > OFF_TAB_END ? (OFF_LW + (size_t)NEXP * LISTCAP * 4) : OFF_TAB_END;
static_assert(WS_NEED <= 268435456, "workspace budget");

struct Params {
    const float* x; const float* norm1_w; const float* w_in; const float* gla_w2_f; const float* gla_b_f; const float* gla_w2_b; const float* gla_b_b;
    const float* gla_norm_w; const float* conv_w; const float* a_log_f; const float* dt_bias_f; const float* a_log_b; const float* dt_bias_b; const float* gdn_norm_w;
    const float* w_out; const float* norm2_w; const float* w_group; const float* w_router; const float* w_gate; const float* w_up; const float* w_down; const float* norm_f_w;
    float* out; unsigned char* ws;
    int ph_lo, ph_hi;
};

__device__ __forceinline__ unsigned f2bf(float f) { unsigned u = __float_as_uint(f); return (u + 0x7fffu + ((u >> 16) & 1u)) >> 16; }
__device__ __forceinline__ float bf2f(unsigned short b) { return __uint_as_float(((unsigned)b) << 16); }
__device__ __forceinline__ unsigned pk2(float lo, float hi) { return f2bf(lo) | (f2bf(hi) << 16); }
__device__ __forceinline__ float bflo(unsigned w) { return __uint_as_float(w << 16); }
__device__ __forceinline__ float bfhi(unsigned w) { return __uint_as_float(w & 0xffff0000u); }
__device__ __forceinline__ float wave_sum(float v) {
#pragma unroll
    for (int o = 1; o < 64; o <<= 1) v += __shfl_xor(v, o);
    return v;
}
__device__ __forceinline__ float sigmoid_f(float x) { return __builtin_amdgcn_rcpf(1.f + __expf(-x)); }
__device__ __forceinline__ float silu_f(float x) { return x * __builtin_amdgcn_rcpf(1.f + __expf(-x)); }
#define LDS_WAIT() asm volatile("s_waitcnt lgkmcnt(0)" ::: "memory")
#ifndef SPIN_K
#define SPIN_K -1
#endif
#ifndef SPIN_A
#define SPIN_A -1
#endif
#ifndef SPIN_B
#define SPIN_B -1
#endif
#define LSTAMP(lds_, k) do { if ((SPIN_K >= 0 || SPIN_A >= 0) && blockIdx.x == 0 && threadIdx.x == 0) ((volatile LAS unsigned long long*)((lds_) + LDS_BYTES - 256))[k] = __builtin_amdgcn_s_memrealtime(); } while (0)
__device__ __forceinline__ int lane_id() { return (int)__builtin_amdgcn_mbcnt_hi(~0u, __builtin_amdgcn_mbcnt_lo(~0u, 0u)); }
#define TID(wv) ((wv) * 64 + lane_id())

namespace pg8 {
constexpr int BM = 256, BK = 64, HALF = 128, HTB = HALF * BK * 2, STAGE_BYTES = 8 * HTB, NXCD = 8, WGM = 8;
__host__ __device__ __forceinline__ int lds_byte(int r, int c) { const int st = (r >> 4) * 2 + (c >> 5), rr = r & 15, cc = c & 31, ob = rr * 64 + cc * 2; return st * 1024 + (ob ^ (((ob >> 9) & 1) << 5)); }
__host__ __device__ __forceinline__ void stage_rc(int b, int& R, int& C) { const int st = b / 1024, sb = b % 1024, swz = sb ^ (((sb >> 9) & 1) << 5); R = (st >> 1) * 16 + swz / 64; C = (st & 1) * 32 + (swz % 64) / 2; }
__host__ __device__ __forceinline__ int perm32(int rho) { const int n = rho >> 4, i = rho & 15; return 8 * (i >> 2) + 4 * n + (i & 3); }
struct Unit { int pm, pn; };
struct Gemm { const bf16_t* A; const bf16_t* Bt; int M, N, K; };
struct StaticOrder {
    int nM, nN, nwg, G, c;
    __host__ __device__ void init(int M, int N, int G_, int c_) { nM = M / BM; nN = N / BM; nwg = nM * nN; G = G_; c = c_; }
    __host__ __device__ bool next(int i, Unit& u) const {
        const long L = (long)i * G + c; if (L >= nwg) return false;
        int wgid = (int)L; { const int q = nwg / NXCD, r = nwg % NXCD, xcd = wgid % NXCD, off = wgid / NXCD; wgid = (xcd < r ? xcd * (q + 1) : r * (q + 1) + (xcd - r) * q) + off; }
        const int nig = WGM * nN, gid = wgid / nig, fm = gid * WGM, gsz = (nM - fm) < WGM ? (nM - fm) : WGM;
        u.pm = fm + ((wgid % nig) % gsz); u.pn = (wgid % nig) / gsz; return true;
    }
    __device__ __forceinline__ void a_ready(const Unit&) const {}
    __device__ __forceinline__ void done(const Unit&) const {}
};
__device__ __forceinline__ unsigned cvt_pk_bf16(float lo, float hi) { unsigned r; asm volatile("v_cvt_pk_bf16_f32 %0, %1, %2" : "=v"(r) : "v"(lo), "v"(hi)); return r; }

struct EpiBf16 {
    static constexpr bool PERM = true;
    bf16_t* O; int ldc;
    __device__ __forceinline__ void operator()(const f32x4 (&acc)[2][2][4][2], const Unit& u, int wr, int wc, int fr, int fq) const {
        const int row0 = u.pm * BM + wr * 64 + fr, col0 = u.pn * BM + wc * 32 + 8 * fq;
#pragma unroll
        for (int ai = 0; ai < 2; ++ai)
#pragma unroll
            for (int m = 0; m < 4; ++m) { bf16_t* rowp = O + (size_t)(row0 + ai * HALF + m * 16) * ldc + col0;
#pragma unroll
                for (int bj = 0; bj < 2; ++bj) { const f32x4 v0 = acc[ai][bj][m][0], v1 = acc[ai][bj][m][1];
                    u32x4 w; w.x = cvt_pk_bf16(v0[0], v0[1]); w.y = cvt_pk_bf16(v0[2], v0[3]); w.z = cvt_pk_bf16(v1[0], v1[1]); w.w = cvt_pk_bf16(v1[2], v1[3]);
                    *(u32x4*)(rowp + bj * HALF) = w; } }
    }
};
struct EpiMix {
    static constexpr bool PERM = true;
    const bf16_t* __restrict__ oa_; const bf16_t* __restrict__ ob_; bf16_t* __restrict__ mixed; const float* __restrict__ part; const float* gw_a; const float* gw_b;
    __device__ __forceinline__ void operator()(const f32x4 (&acc)[2][2][4][2], const Unit& u, int wr, int wc, int fr, int fq) const {
        const int row0 = u.pm * BM + wr * 64 + fr, mc0 = u.pn * 64 + wc * 16 + 4 * fq;
        const f32x4 ga = *(const f32x4*)(gw_a + (mc0 & 255)), gb = *(const f32x4*)(gw_b + (mc0 & 127));
        const int pa = (u.pn >> 2) * 8, pb = 32 + (u.pn >> 1) * 4;
#pragma unroll
        for (int ai = 0; ai < 2; ++ai) {
            u32x2 oa[4], ob[4]; float pv[4];
#pragma unroll
            for (int m = 0; m < 4; ++m) { const int row = row0 + ai * HALF + m * 16; const size_t off = (size_t)row * D + mc0;
                oa[m] = *(const u32x2*)(oa_ + off); ob[m] = *(const u32x2*)(ob_ + off);
                const f32x4 sv = *(const f32x4*)(part + (size_t)row * 64 + (fq == 2 ? pb : pa + 4 * (fq & 1))); pv[m] = (sv.x + sv.y) + (sv.z + sv.w); }
#pragma unroll
            for (int m = 0; m < 4; ++m) { const int row = row0 + ai * HALF + m * 16; const size_t off = (size_t)row * D + mc0;
                const float s01 = __shfl(pv[m], fr) + __shfl(pv[m], fr + 16), s2 = __shfl(pv[m], fr + 32);
                const float ra = rsqrtf(s01 * (1.f / 256.f) + 1e-6f), rb = rsqrtf(s2 * (1.f / 128.f) + 1e-6f);
                const float a4[4] = {bflo(oa[m].x) * ra * ga.x, bfhi(oa[m].x) * ra * ga.y, bflo(oa[m].y) * ra * ga.z, bfhi(oa[m].y) * ra * ga.w};
                const float b4[4] = {bflo(ob[m].x) * rb * gb.x, bfhi(ob[m].x) * rb * gb.y, bflo(ob[m].y) * rb * gb.z, bfhi(ob[m].y) * rb * gb.w};
                float r[4];
#pragma unroll
                for (int i = 0; i < 4; ++i) r[i] = sigmoid_f(acc[ai][0][m][1][i]) * silu_f(acc[ai][0][m][0][i]) * a4[i] + sigmoid_f(acc[ai][1][m][1][i]) * silu_f(acc[ai][1][m][0][i]) * b4[i];
                u32x2 w; w.x = cvt_pk_bf16(r[0], r[1]); w.y = cvt_pk_bf16(r[2], r[3]);
                *(u32x2*)(mixed + off) = w; }
        }
    }
};
struct EpiRes {
    static constexpr bool PERM = false;
    const float* __restrict__ base; float* __restrict__ C; int ldc;
    __device__ __forceinline__ void operator()(const f32x4 (&acc)[2][2][4][2], const Unit& u, int wr, int wc, int fr, int fq) const {
        const int row0 = u.pm * BM + wr * 64 + fr, col0 = u.pn * BM + wc * 32 + 4 * fq;
#pragma unroll
        for (int ai = 0; ai < 2; ++ai)
#pragma unroll
            for (int mh = 0; mh < 2; ++mh) {
                f32x4 b[2][2][2];
#pragma unroll
                for (int mm = 0; mm < 2; ++mm) { const size_t off = (size_t)(row0 + ai * HALF + (2 * mh + mm) * 16) * ldc + col0;
#pragma unroll
                    for (int bj = 0; bj < 2; ++bj)
#pragma unroll
                        for (int n = 0; n < 2; ++n) b[mm][bj][n] = *(const f32x4*)(base + off + bj * HALF + n * 16); }
#pragma unroll
                for (int mm = 0; mm < 2; ++mm) { const size_t off = (size_t)(row0 + ai * HALF + (2 * mh + mm) * 16) * ldc + col0;
#pragma unroll
                    for (int bj = 0; bj < 2; ++bj)
#pragma unroll
                        for (int n = 0; n < 2; ++n) *(f32x4*)(C + off + bj * HALF + n * 16) = b[mm][bj][n] + acc[ai][bj][2 * mh + mm][n]; }
            }
    }
};

template <class Epi, class Sched>
__device__ __forceinline__ void gemm_phase(LAS unsigned char* lds, const Gemm g, const Sched& S, const Epi& E, int wv) {
    const int tid = wv * 64 + (int)__builtin_amdgcn_mbcnt_hi(~0u, __builtin_amdgcn_mbcnt_lo(~0u, 0u)), wid = wv, lane = tid & 63, wr = wid >> 2, wc = wid & 3, fr = lane & 15, fq = lane >> 4;
    const int K = g.K, nt = K / BK;
    unsigned voffA[2], voffB[2];
#pragma unroll
    for (int i = 0; i < 2; ++i) { int R, C; stage_rc(tid * 16 + i * 8192, R, C); const int Rb = Epi::PERM ? ((R & ~31) + perm32(R & 31)) : R;
        voffA[i] = (unsigned)(R * K + C) * 2u; voffB[i] = (unsigned)(Rb * K + C) * 2u; }
    const size_t kstep = (size_t)(BK * 2);
    const size_t hstep = (size_t)HALF * K * 2;
    const size_t tstep = 2 * hstep;
    const unsigned ldsw = (unsigned)wid * 1024u;
    const int aoff = lds_byte(wr * 64 + fr, fq * 8), boff = lds_byte(wc * 32 + fr, fq * 8);
#define PG8_SA(b, h) (((b) * 2 + (h)) * HTB)
#define PG8_SB(b, h) ((4 + (b) * 2 + (h)) * HTB)
#define PG8_STAGE(bufoff, gbase, voff) do { _Pragma("unroll") for (int _i = 0; _i < 2; ++_i) \
        __builtin_amdgcn_global_load_lds((const unsigned*)((const char*)(gbase) + (voff)[_i]), (LAS unsigned*)(lds + (bufoff) + ldsw + _i * 8192), 16, 0, 0); } while (0)
#define PG8_LDA(dst, b, h) do { _Pragma("unroll") for (int m = 0; m < 4; ++m) _Pragma("unroll") for (int k = 0; k < 2; ++k) dst[m][k] = *(const LAS bf16x8*)(lds + PG8_SA(b, h) + aoff + m * 2048 + k * 1024); } while (0)
#define PG8_LDB(dst, b, h) do { _Pragma("unroll") for (int n = 0; n < 2; ++n) _Pragma("unroll") for (int k = 0; k < 2; ++k) dst[n][k] = *(const LAS bf16x8*)(lds + PG8_SB(b, h) + boff + n * 2048 + k * 1024); } while (0)
#define PG8_MMA(ai, bj, At, Bt) do { __builtin_amdgcn_s_setprio(1); _Pragma("unroll") for (int m = 0; m < 4; ++m) _Pragma("unroll") for (int n = 0; n < 2; ++n) _Pragma("unroll") for (int k = 0; k < 2; ++k) \
        acc[ai][bj][m][n] = __builtin_amdgcn_mfma_f32_16x16x32_bf16(Bt[n][k], At[m][k], acc[ai][bj][m][n], 0, 0, 0); __builtin_amdgcn_s_setprio(0); } while (0)
#define PG8_WAIT_V(n) asm volatile("s_waitcnt vmcnt(" #n ")" ::: "memory")
#define PG8_WAIT_L(n) asm volatile("s_waitcnt lgkmcnt(" #n ")" ::: "memory")
#define PG8_BAR __builtin_amdgcn_s_barrier()
#define PG8_SCHED __builtin_amdgcn_sched_barrier(0)
    Unit cur, nxt; int ui = 0;
    if (!S.next(0, cur)) return;
    f32x4 acc[2][2][4][2];
#pragma unroll
    for (int a = 0; a < 2; ++a)
#pragma unroll
        for (int b = 0; b < 2; ++b)
#pragma unroll
            for (int m = 0; m < 4; ++m)
#pragma unroll
                for (int n = 0; n < 2; ++n) acc[a][b][m][n] = (f32x4){0.f, 0.f, 0.f, 0.f};
    bf16x8 At[4][2], B0[2][2], B1[2][2];
    const char* cA = (const char*)g.A + (size_t)cur.pm * tstep; const char* cB = (const char*)g.Bt + (size_t)cur.pn * tstep;
    S.a_ready(cur);
    PG8_STAGE(PG8_SB(0, 0), cB, voffB); PG8_STAGE(PG8_SA(0, 0), cA, voffA); PG8_STAGE(PG8_SB(0, 1), cB + hstep, voffB); PG8_STAGE(PG8_SA(0, 1), cA + hstep, voffA);
    if (wr == 1) PG8_BAR;
    PG8_WAIT_V(4); PG8_BAR;
    PG8_STAGE(PG8_SB(1, 0), cB + kstep, voffB); PG8_STAGE(PG8_SA(1, 0), cA + kstep, voffA); PG8_STAGE(PG8_SB(1, 1), cB + hstep + kstep, voffB);
    PG8_WAIT_V(6); PG8_BAR;
    for (;;) {
        const bool has_next = S.next(ui + 1, nxt);
        const char* nA = has_next ? (const char*)g.A + (size_t)nxt.pm * tstep : cA; const char* nB = has_next ? (const char*)g.Bt + (size_t)nxt.pn * tstep : cB;
        for (int t = 0; t < nt; t += 2) {
            const bool last = (t == nt - 2);
            const char* a1 = cA + (size_t)(t + 1) * kstep;
            const char* a2 = last ? nA : cA + (size_t)(t + 2) * kstep; const char* b2 = last ? nB : cB + (size_t)(t + 2) * kstep;
            const char* a3 = a2 + kstep; const char* b3 = b2 + kstep;
            if (last && has_next) S.a_ready(nxt);
            PG8_LDB(B0, 0, 0); PG8_SCHED; PG8_LDA(At, 0, 0); PG8_STAGE(PG8_SA(1, 1), a1 + hstep, voffA);
            PG8_WAIT_L(8); PG8_BAR; PG8_WAIT_L(0); PG8_MMA(0, 0, At, B0); PG8_BAR; PG8_SCHED;
            PG8_LDB(B1, 0, 1); PG8_STAGE(PG8_SB(0, 0), b2, voffB);
            PG8_BAR; PG8_WAIT_L(0); PG8_MMA(0, 1, At, B1); PG8_BAR;
            PG8_LDA(At, 0, 1); PG8_STAGE(PG8_SA(0, 0), a2, voffA);
            PG8_BAR; PG8_WAIT_L(0); PG8_MMA(1, 0, At, B0); PG8_BAR; PG8_SCHED;
            PG8_STAGE(PG8_SB(0, 1), b2 + hstep, voffB);
            PG8_WAIT_V(6); PG8_BAR; PG8_MMA(1, 1, At, B1); PG8_BAR;
            PG8_LDB(B0, 1, 0); PG8_SCHED; PG8_LDA(At, 1, 0); PG8_STAGE(PG8_SA(0, 1), a2 + hstep, voffA);
            PG8_WAIT_L(8); PG8_BAR; PG8_WAIT_L(0); PG8_MMA(0, 0, At, B0); PG8_BAR; PG8_SCHED;
            PG8_LDB(B1, 1, 1); PG8_STAGE(PG8_SB(1, 0), b3, voffB);
            PG8_BAR; PG8_WAIT_L(0); PG8_MMA(0, 1, At, B1); PG8_BAR;
            PG8_LDA(At, 1, 1); PG8_STAGE(PG8_SA(1, 0), a3, voffA);
            PG8_BAR; PG8_WAIT_L(0); PG8_MMA(1, 0, At, B0); PG8_BAR; PG8_SCHED;
            PG8_STAGE(PG8_SB(1, 1), b3 + hstep, voffB);
            PG8_WAIT_V(6); PG8_BAR; PG8_MMA(1, 1, At, B1); PG8_BAR;
        }
        E(acc, cur, wr, wc, fr, fq); S.done(cur);
        if (!has_next) break;
#pragma unroll
        for (int a = 0; a < 2; ++a)
#pragma unroll
            for (int b = 0; b < 2; ++b)
#pragma unroll
                for (int m = 0; m < 4; ++m)
#pragma unroll
                    for (int n = 0; n < 2; ++n) acc[a][b][m][n] = (f32x4){0.f, 0.f, 0.f, 0.f};
        cur = nxt; cA = nA; cB = nB; ++ui;
    }
    PG8_WAIT_V(0);
    if (wr == 0) PG8_BAR;
    PG8_BAR;
#undef PG8_SA
#undef PG8_SB
#undef PG8_STAGE
#undef PG8_LDA
#undef PG8_LDB
#undef PG8_MMA
#undef PG8_WAIT_V
#undef PG8_WAIT_L
#undef PG8_BAR
#undef PG8_SCHED
}

struct MoeSched {
    const LAS int* tabE; const LAS int* tabLB; const LAS int* tabCnt; int NU, NPN, G, c;
    __device__ __forceinline__ bool next(int i, Unit& u) const { const long L = (long)i * G + c; if (L >= (long)NU * NPN) return false; u.pm = (int)(L / NPN); u.pn = (int)(L % NPN); return true; }
};
struct EpiSwiGLU {
    static constexpr bool PERM = true;
    bf16_t* hid;
    __device__ __forceinline__ void operator()(const f32x4 (&acc)[2][2][4][2], const Unit& u, int e, int lb, int cnt, int wr, int wc, int fr, int fq) const {
        const int row0 = u.pm * BM + wr * 64 + fr, hc0 = u.pn * 128 + wc * 16 + 4 * fq;
#pragma unroll
        for (int ai = 0; ai < 2; ++ai)
#pragma unroll
            for (int m = 0; m < 4; ++m) { bf16_t* rowp = hid + (size_t)(row0 + ai * HALF + m * 16) * DEXP + hc0;
#pragma unroll
                for (int bj = 0; bj < 2; ++bj) { const f32x4 g = acc[ai][bj][m][0], up = acc[ai][bj][m][1];
                    u32x2 w; w.x = cvt_pk_bf16(silu_f(g[0]) * up[0], silu_f(g[1]) * up[1]); w.y = cvt_pk_bf16(silu_f(g[2]) * up[2], silu_f(g[3]) * up[3]);
                    *(u32x2*)(rowp + bj * 64) = w; } }
    }
};
struct EpiScatter {
    static constexpr bool PERM = true;
    bf16_t* yb; const int* lslot; const float* lw;
    __device__ __forceinline__ void operator()(const f32x4 (&acc)[2][2][4][2], const Unit& u, int e, int lb, int cnt, int wr, int wc, int fr, int fq) const {
        const int a0 = lb * BM + wr * 64 + fr, col0 = u.pn * BM + wc * 32 + 8 * fq;
#pragma unroll
        for (int ai = 0; ai < 2; ++ai)
#pragma unroll
            for (int m = 0; m < 4; ++m) { const int a = a0 + ai * HALF + m * 16;
                if (a < cnt) { const int slot = lslot[e * LISTCAP + a]; const float w = lw[e * LISTCAP + a]; bf16_t* rowp = yb + (size_t)slot * D + col0;
#pragma unroll
                    for (int bj = 0; bj < 2; ++bj) { const f32x4 v0 = acc[ai][bj][m][0] * w, v1 = acc[ai][bj][m][1] * w;
                        u32x4 o; o.x = cvt_pk_bf16(v0[0], v0[1]); o.y = cvt_pk_bf16(v0[2], v0[3]); o.z = cvt_pk_bf16(v1[0], v1[1]); o.w = cvt_pk_bf16(v1[2], v1[3]);
                        *(u32x4*)(rowp + bj * HALF) = o; } } }
    }
};
template <class Epi, bool GATHER>
__device__ __forceinline__ void gemm_phase_moe(LAS unsigned char* lds, const bf16_t* A, const bf16_t* Bt_all, int K, int brows, const MoeSched& S, const Epi& E, const int* lslot, int wv) {
    const int tid = wv * 64 + (int)__builtin_amdgcn_mbcnt_hi(~0u, __builtin_amdgcn_mbcnt_lo(~0u, 0u)), wid = wv, lane = tid & 63, wr = wid >> 2, wc = wid & 3, fr = lane & 15, fq = lane >> 4;
    const int nt = K / BK;
    int sR[2], sC[2]; unsigned voffB[2];
#pragma unroll
    for (int i = 0; i < 2; ++i) { int R, C; stage_rc(tid * 16 + i * 8192, R, C); sR[i] = R; sC[i] = C; const int Rb = (R & ~31) + perm32(R & 31); voffB[i] = (unsigned)(Rb * K + C) * 2u; }
    const size_t kstep = (size_t)(BK * 2), hstepB = (size_t)HALF * K * 2, tstepB = 2 * hstepB;
    const unsigned ldsw = (unsigned)wid * 1024u;
    const int aoff = lds_byte(wr * 64 + fr, fq * 8), boff = lds_byte(wc * 32 + fr, fq * 8);
    auto a_offsets = [&](const Unit& u, unsigned (&v0)[2], unsigned (&v1)[2]) {
        if (GATHER) { const int e = S.tabE[u.pm], lb = S.tabLB[u.pm], cnt = S.tabCnt[e];
#pragma unroll
            for (int i = 0; i < 2; ++i) { const int a0 = lb * BM + sR[i], a1 = a0 + HALF;
                const int t0 = a0 < cnt ? (lslot[e * LISTCAP + a0] >> 1) : 0, t1 = a1 < cnt ? (lslot[e * LISTCAP + a1] >> 1) : 0;
                v0[i] = (unsigned)(t0 * K + sC[i]) * 2u; v1[i] = (unsigned)(t1 * K + sC[i]) * 2u; } }
        else {
#pragma unroll
            for (int i = 0; i < 2; ++i) { v0[i] = (unsigned)((u.pm * BM + sR[i]) * K + sC[i]) * 2u; v1[i] = v0[i] + (unsigned)(HALF * K * 2); } }
    };
#define PG8_SA(b, h) (((b) * 2 + (h)) * HTB)
#define PG8_SB(b, h) ((4 + (b) * 2 + (h)) * HTB)
#define PG8_STAGE(bufoff, gbase, voff) do { _Pragma("unroll") for (int _i = 0; _i < 2; ++_i) \
        __builtin_amdgcn_global_load_lds((const unsigned*)((const char*)(gbase) + (voff)[_i]), (LAS unsigned*)(lds + (bufoff) + ldsw + _i * 8192), 16, 0, 0); } while (0)
#define PG8_LDA(dst, b, h) do { _Pragma("unroll") for (int m = 0; m < 4; ++m) _Pragma("unroll") for (int k = 0; k < 2; ++k) dst[m][k] = *(const LAS bf16x8*)(lds + PG8_SA(b, h) + aoff + m * 2048 + k * 1024); } while (0)
#define PG8_LDB(dst, b, h) do { _Pragma("unroll") for (int n = 0; n < 2; ++n) _Pragma("unroll") for (int k = 0; k < 2; ++k) dst[n][k] = *(const LAS bf16x8*)(lds + PG8_SB(b, h) + boff + n * 2048 + k * 1024); } while (0)
#define PG8_MMA(ai, bj, At, Bt) do { __builtin_amdgcn_s_setprio(1); _Pragma("unroll") for (int m = 0; m < 4; ++m) _Pragma("unroll") for (int n = 0; n < 2; ++n) _Pragma("unroll") for (int k = 0; k < 2; ++k) \
        acc[ai][bj][m][n] = __builtin_amdgcn_mfma_f32_16x16x32_bf16(Bt[n][k], At[m][k], acc[ai][bj][m][n], 0, 0, 0); __builtin_amdgcn_s_setprio(0); } while (0)
#define PG8_WAIT_V(n) asm volatile("s_waitcnt vmcnt(" #n ")" ::: "memory")
#define PG8_WAIT_L(n) asm volatile("s_waitcnt lgkmcnt(" #n ")" ::: "memory")
#define PG8_BAR __builtin_amdgcn_s_barrier()
#define PG8_SCHED __builtin_amdgcn_sched_barrier(0)
    Unit cur, nxt; int ui = 0;
    if (!S.next(0, cur)) return;
    f32x4 acc[2][2][4][2];
#pragma unroll
    for (int a = 0; a < 2; ++a)
#pragma unroll
        for (int b = 0; b < 2; ++b)
#pragma unroll
            for (int m = 0; m < 4; ++m)
#pragma unroll
                for (int n = 0; n < 2; ++n) acc[a][b][m][n] = (f32x4){0.f, 0.f, 0.f, 0.f};
    bf16x8 At[4][2], B0[2][2], B1[2][2];
    unsigned va0[2], va1[2], na0[2], na1[2];
    a_offsets(cur, va0, va1);
    asm volatile("s_waitcnt vmcnt(0)" ::: "memory");
    const char* cA = (const char*)A; const char* cB = (const char*)Bt_all + ((size_t)S.tabE[cur.pm] * brows + (size_t)cur.pn * BM) * K * 2;
    PG8_STAGE(PG8_SB(0, 0), cB, voffB); PG8_STAGE(PG8_SA(0, 0), cA, va0); PG8_STAGE(PG8_SB(0, 1), cB + hstepB, voffB); PG8_STAGE(PG8_SA(0, 1), cA, va1);
    if (wr == 1) PG8_BAR;
    PG8_WAIT_V(4); PG8_BAR;
    PG8_STAGE(PG8_SB(1, 0), cB + kstep, voffB); PG8_STAGE(PG8_SA(1, 0), cA + kstep, va0); PG8_STAGE(PG8_SB(1, 1), cB + hstepB + kstep, voffB);
    PG8_WAIT_V(6); PG8_BAR;
    for (;;) {
        const bool has_next = S.next(ui + 1, nxt);
        const char* nB = has_next ? (const char*)Bt_all + ((size_t)S.tabE[nxt.pm] * brows + (size_t)nxt.pn * BM) * K * 2 : cB;
        if (has_next) a_offsets(nxt, na0, na1);
        else {
#pragma unroll
            for (int i = 0; i < 2; ++i) { na0[i] = va0[i]; na1[i] = va1[i]; } }
        for (int t = 0; t < nt; t += 2) {
            const bool last = (t == nt - 2);
            const char* a1 = cA + (size_t)(t + 1) * kstep;
            const char* a2 = last ? cA : cA + (size_t)(t + 2) * kstep; const char* b2 = last ? nB : cB + (size_t)(t + 2) * kstep;
            const char* a3 = a2 + kstep; const char* b3 = b2 + kstep;
            unsigned x0[2], x1[2];
#pragma unroll
            for (int i = 0; i < 2; ++i) { x0[i] = last ? na0[i] : va0[i]; x1[i] = last ? na1[i] : va1[i]; }
            PG8_LDB(B0, 0, 0); PG8_SCHED; PG8_LDA(At, 0, 0); PG8_STAGE(PG8_SA(1, 1), a1, va1);
            PG8_WAIT_L(8); PG8_BAR; PG8_WAIT_L(0); PG8_MMA(0, 0, At, B0); PG8_BAR; PG8_SCHED;
            PG8_LDB(B1, 0, 1); PG8_STAGE(PG8_SB(0, 0), b2, voffB);
            PG8_BAR; PG8_WAIT_L(0); PG8_MMA(0, 1, At, B1); PG8_BAR;
            PG8_LDA(At, 0, 1); PG8_STAGE(PG8_SA(0, 0), a2, x0);
            PG8_BAR; PG8_WAIT_L(0); PG8_MMA(1, 0, At, B0); PG8_BAR; PG8_SCHED;
            PG8_STAGE(PG8_SB(0, 1), b2 + hstepB, voffB);
            PG8_WAIT_V(6); PG8_BAR; PG8_MMA(1, 1, At, B1); PG8_BAR;
            PG8_LDB(B0, 1, 0); PG8_SCHED; PG8_LDA(At, 1, 0); PG8_STAGE(PG8_SA(0, 1), a2, x1);
            PG8_WAIT_L(8); PG8_BAR; PG8_WAIT_L(0); PG8_MMA(0, 0, At, B0); PG8_BAR; PG8_SCHED;
            PG8_LDB(B1, 1, 1); PG8_STAGE(PG8_SB(1, 0), b3, voffB);
            PG8_BAR; PG8_WAIT_L(0); PG8_MMA(0, 1, At, B1); PG8_BAR;
            PG8_LDA(At, 1, 1); PG8_STAGE(PG8_SA(1, 0), a3, x0);
            PG8_BAR; PG8_WAIT_L(0); PG8_MMA(1, 0, At, B0); PG8_BAR; PG8_SCHED;
            PG8_STAGE(PG8_SB(1, 1), b3 + hstepB, voffB);
            PG8_WAIT_V(6); PG8_BAR; PG8_MMA(1, 1, At, B1); PG8_BAR;
        }
        { const int e = S.tabE[cur.pm]; E(acc, cur, e, S.tabLB[cur.pm], S.tabCnt[e], wr, wc, fr, fq); }
        if (!has_next) break;
#pragma unroll
        for (int a = 0; a < 2; ++a)
#pragma unroll
            for (int b = 0; b < 2; ++b)
#pragma unroll
                for (int m = 0; m < 4; ++m)
#pragma unroll
                    for (int n = 0; n < 2; ++n) acc[a][b][m][n] = (f32x4){0.f, 0.f, 0.f, 0.f};
        cur = nxt; cB = nB; ++ui;
#pragma unroll
        for (int i = 0; i < 2; ++i) { va0[i] = na0[i]; va1[i] = na1[i]; }
    }
    PG8_WAIT_V(0);
    if (wr == 0) PG8_BAR;
    PG8_BAR;
#undef PG8_SA
#undef PG8_SB
#undef PG8_STAGE
#undef PG8_LDA
#undef PG8_LDB
#undef PG8_MMA
#undef PG8_WAIT_V
#undef PG8_WAIT_L
#undef PG8_BAR
#undef PG8_SCHED
}
}

template <class RowPtr>
__device__ __forceinline__ void transpose_item(const float* W, int ldw, int k0, int n0, const float* kscale, LAS float* scr, int lane, const RowPtr& rowptr) {
    f32x4 v[8];
#pragma unroll
    for (int i = 0; i < 8; ++i) v[i] = *(const f32x4*)(W + (size_t)(k0 + 8 * i + (lane >> 3)) * ldw + n0 + 4 * (lane & 7));
#pragma unroll
    for (int i = 0; i < 8; ++i) { const int kk = 8 * i + (lane >> 3); const float sc = kscale ? kscale[k0 + kk] : 1.f; LAS float* d = scr + kk * 33 + 4 * (lane & 7);
        d[0] = v[i].x * sc; d[1] = v[i].y * sc; d[2] = v[i].z * sc; d[3] = v[i].w * sc; }
    LDS_WAIT();
    const int c = lane & 7;
#pragma unroll
    for (int j = 0; j < 4; ++j) { const int n = (lane >> 3) + 8 * j; const LAS float* s = scr + (8 * c) * 33 + n;
        u32x4 o; o.x = pg8::cvt_pk_bf16(s[0 * 33], s[1 * 33]); o.y = pg8::cvt_pk_bf16(s[2 * 33], s[3 * 33]); o.z = pg8::cvt_pk_bf16(s[4 * 33], s[5 * 33]); o.w = pg8::cvt_pk_bf16(s[6 * 33], s[7 * 33]);
        *(u32x4*)(rowptr(n0 + n) + k0 + 8 * c) = o; }
    LDS_WAIT();
}

struct WinRow {
    bf16_t* wt1; bf16_t* wt3;
    __device__ __forceinline__ bf16_t* operator()(int c) const {
        if (c < 2048) return wt1 + (size_t)c * D;
        if (c < 3072) { const int cc = c - 2048; return wt3 + (size_t)(256 * (cc >> 6) + 8 * ((cc & 63) >> 2) + (cc & 3)) * D; }
        if (c < 3104) return wt1 + (size_t)(C_GLR + (c - 3072)) * D;
        if (c < 6176) return wt1 + (size_t)(C_DQ + (c - 3104)) * D;
        if (c < 7200) { const int cc = c - 6176; return wt3 + (size_t)(256 * (cc >> 6) + 128 + 8 * ((cc & 63) >> 2) + (cc & 3)) * D; }
        if (c < 7232) return wt1 + (size_t)(C_DAB + (c - 7200)) * D;
        if (c < 8256) { const int cc = c - 7232; return wt3 + (size_t)(256 * (cc >> 6) + 8 * ((cc & 63) >> 2) + 4 + (cc & 3)) * D; }
        { const int cc = c - 8256; return wt3 + (size_t)(256 * (cc >> 6) + 128 + 8 * ((cc & 63) >> 2) + 4 + (cc & 3)) * D; }
    }
};
struct PlainRow { bf16_t* base; int K; __device__ __forceinline__ bf16_t* operator()(int c) const { return base + (size_t)c * K; } };
struct GuRow { bf16_t* base; int up; __device__ __forceinline__ bf16_t* operator()(int c) const { return base + (size_t)(8 * (c >> 2) + 4 * up + (c & 3)) * D; } };

__device__ __forceinline__ void p0_prologue(const Params& p, LAS unsigned char* lds, int wv) {
    const int tid = TID(wv), lane = tid & 63, wave = wv;
    const int gw = blockIdx.x * NWAVES + wave, NGW = gridDim.x * NWAVES;
    LAS float* scr = (LAS float*)(lds + wave * 8448);
    bf16_t* wt1 = (bf16_t*)(p.ws + OFF_WT1); bf16_t* wt3 = (bf16_t*)(p.ws + OFF_WT3); bf16_t* wto = (bf16_t*)(p.ws + OFF_WTO); bf16_t* xn = (bf16_t*)(p.ws + OFF_XN);
    const WinRow wr{wt1, wt3};
    constexpr int I_IN = 16 * (DIN / 32), I_OUT = 16 * (D / 32);
    for (int it = gw; it < I_IN + I_OUT; it += NGW) {
        if (it < I_IN) { const int kb = it / (DIN / 32), nb = it % (DIN / 32); transpose_item(p.w_in, DIN, kb * 64, nb * 32, p.norm1_w, scr, lane, wr); }
        else { const int r = it - I_IN, kb = r / (D / 32), nb = r % (D / 32); transpose_item(p.w_out, D, kb * 64, nb * 32, nullptr, scr, lane, PlainRow{wto, D}); }
    }
    LSTAMP(lds, 16);
    { const int gt = blockIdx.x * NTHR + tid, NGT = gridDim.x * NTHR; u32x4* z = (u32x4*)(wt1 + (size_t)N1_USED * D); const int nz = (N1 - N1_USED) * D / 8;
      for (int i = gt; i < nz; i += NGT) z[i] = (u32x4){0u, 0u, 0u, 0u}; }
    for (int m = gw; m < NTOK; m += NGW) {
        const f32x4* xr = (const f32x4*)(p.x + (size_t)m * D) + lane;
        f32x4 v[4]; float s = 0.f;
#pragma unroll
        for (int j = 0; j < 4; ++j) { v[j] = xr[64 * j]; s += (v[j].x * v[j].x + v[j].y * v[j].y) + (v[j].z * v[j].z + v[j].w * v[j].w); }
        const float rstd = rsqrtf(wave_sum(s) * (1.f / D) + EPS);
        u32x2* o8 = (u32x2*)(xn + (size_t)m * D) + lane;
#pragma unroll
        for (int j = 0; j < 4; ++j) { u32x2 w; w.x = pk2(v[j].x * rstd, v[j].y * rstd); w.y = pk2(v[j].z * rstd, v[j].w * rstd); o8[64 * j] = w; }
    }
}

typedef float f32x16 __attribute__((ext_vector_type(16)));
typedef short s16x4 __attribute__((ext_vector_type(4)));
typedef __bf16 bf16x2_t __attribute__((ext_vector_type(2)));
#define MFMA32(a, b, c) __builtin_amdgcn_mfma_f32_32x32x16_bf16((a), (b), (c), 0, 0, 0)
__device__ __forceinline__ unsigned cvt2(float a, float b) { const f32x2 v = {a, b}; return __builtin_bit_cast(unsigned, __builtin_convertvector(v, bf16x2_t)); }
template <int S_> __device__ __forceinline__ bf16x8 pack8(const f32x16& x) {
    u32x4 q; q.x = cvt2(x[8 * S_], x[8 * S_ + 1]); q.y = cvt2(x[8 * S_ + 2], x[8 * S_ + 3]); q.z = cvt2(x[8 * S_ + 4], x[8 * S_ + 5]); q.w = cvt2(x[8 * S_ + 6], x[8 * S_ + 7]);
    return __builtin_bit_cast(bf16x8, q);
}
__device__ __forceinline__ int crow(int reg, int h) { return (reg & 3) + 8 * (reg >> 2) + 4 * h; }
__device__ __forceinline__ unsigned offb(unsigned row, unsigned ch) { return 256u * row + 16u * (ch ^ (((row & 3u) << 2) | ((row >> 2) & 3u))); }
__device__ __forceinline__ bf16x8 rowfrag_nat(const LAS unsigned char* img, int ks, int lane) { return *(const LAS bf16x8*)(img + offb(lane & 31, 2 * ks + (lane >> 5))); }
__device__ __forceinline__ bf16x8 rowfrag_perm(const LAS unsigned char* img, int ks, int lane) {
    const unsigned row = lane & 31, h8 = 8u * (lane >> 5);
    const s16x4 lo = *(const LAS s16x4*)(img + offb(row, 2 * ks) + h8), hi = *(const LAS s16x4*)(img + offb(row, 2 * ks + 1) + h8);
    return __builtin_shufflevector(lo, hi, 0, 1, 2, 3, 4, 5, 6, 7);
}
__device__ __forceinline__ bf16x8 trfrag_perm(const LAS unsigned char* img, int c, int ks, int lane) {
    const unsigned h = lane >> 5, blk = (lane >> 4) & 1, q = (lane & 15) >> 2, pp = lane & 3;
    const unsigned a0 = offb(16 * ks + 4 * h + q, 4 * c + 2 * blk + (pp >> 1)) + 8 * (pp & 1), a1 = offb(16 * ks + 4 * h + 8 + q, 4 * c + 2 * blk + (pp >> 1)) + 8 * (pp & 1);
    const s16x4 lo = __builtin_amdgcn_ds_read_tr16_b64_v4i16((LAS s16x4*)(img + a0)), hi = __builtin_amdgcn_ds_read_tr16_b64_v4i16((LAS s16x4*)(img + a1));
    return __builtin_shufflevector(lo, hi, 0, 1, 2, 3, 4, 5, 6, 7);
}
__device__ __forceinline__ f32x16 zero16() { f32x16 z;
#pragma unroll
    for (int i = 0; i < 16; ++i) z[i] = 0.f; return z; }


__device__ __forceinline__ void p1b_conv_item(const Params& p, int b, int part, int h, int wv) {
    const int tid = TID(wv), lane = tid & 63, wave = wv;
    const int ch = part * 1024 + h * 128 + 2 * lane;
    bf16_t* base = (bf16_t*)(p.ws + OFF_PROJ) + (size_t)b * SEQ * N1 + C_DQ + ch;
    float cw0[5], cw1[5];
#pragma unroll
    for (int j = 0; j < 5; ++j) { cw0[j] = p.conv_w[j * 3072 + ch]; cw1[j] = p.conv_w[j * 3072 + ch + 1]; }
    const int s0 = wave * 256, s1 = s0 + 256;
    const unsigned hm2 = (s0 >= 2) ? *(const unsigned*)(base + (size_t)(s0 - 2) * N1) : 0u, hm1 = (s0 >= 1) ? *(const unsigned*)(base + (size_t)(s0 - 1) * N1) : 0u;
    const unsigned hp0 = (s1 < SEQ) ? *(const unsigned*)(base + (size_t)s1 * N1) : 0u, hp1 = (s1 + 1 < SEQ) ? *(const unsigned*)(base + (size_t)(s1 + 1) * N1) : 0u;
    unsigned raw[12], nx[8];
    raw[8] = hm2; raw[9] = hm1; raw[10] = *(const unsigned*)(base + (size_t)s0 * N1); raw[11] = *(const unsigned*)(base + (size_t)(s0 + 1) * N1);
#pragma unroll
    for (int j = 0; j < 8; ++j) nx[j] = *(const unsigned*)(base + (size_t)(s0 + 2 + j) * N1);
    asm volatile("s_waitcnt vmcnt(0)" ::: "memory");
    __syncthreads();
    const float qs = part == 0 ? 0.08838834764831845f : 1.f;
    for (int t0 = s0; t0 < s1; t0 += 8) {
#pragma unroll
        for (int j = 0; j < 4; ++j) raw[j] = raw[8 + j];
#pragma unroll
        for (int j = 0; j < 8; ++j) raw[4 + j] = nx[j];
        if (t0 + 8 < s1) {
#pragma unroll
            for (int j = 0; j < 8; ++j) { const int t = t0 + 10 + j; nx[j] = (t < s1) ? *(const unsigned*)(base + (size_t)t * N1) : (t == s1 ? hp0 : hp1); } }
        float a0[8], a1[8], ss[8];
#pragma unroll
        for (int j = 0; j < 8; ++j) { float x0 = 0.f, x1 = 0.f;
#pragma unroll
            for (int q = 0; q < 5; ++q) { x0 += cw0[q] * bflo(raw[j + q]); x1 += cw1[q] * bfhi(raw[j + q]); }
            a0[j] = silu_f(x0); a1[j] = silu_f(x1); ss[j] = a0[j] * a0[j] + a1[j] * a1[j]; }
        if (part < 2) {
#pragma unroll
            for (int j = 0; j < 8; ++j) { const float rs = rsqrtf(wave_sum(ss[j]) + EPS) * qs; a0[j] *= rs; a1[j] *= rs; } }
#pragma unroll
        for (int j = 0; j < 8; ++j) *(unsigned*)(base + (size_t)(t0 + j) * N1) = cvt2(a0[j], a1[j]);
    }
}
__device__ __forceinline__ float log_sigmoid_f(float z) { return fminf(z, 0.f) - log1pf(expf(-fabsf(z))); }
__device__ __forceinline__ float softplus_f(float z) { return z > 20.f ? z : log1pf(expf(z)); }

__device__ __forceinline__ void p1b_prepass(const Params& p, LAS unsigned char* lds, int wv, int parts = 7) {
    const int tid = TID(wv), lane = tid & 63;
    const bf16_t* proj = (const bf16_t*)(p.ws + OFF_PROJ);
    if (parts & 1) { float* gt = (float*)(p.ws + OFF_GT); float* bt = (float*)(p.ws + OFF_BT);
      for (int idx = blockIdx.x * NTHR + tid; idx < 2 * NB * 8 * SEQ; idx += gridDim.x * NTHR) {
          const int t = idx & 2047, h = (idx >> 11) & 7, b = (idx >> 14) & 7, dir = idx >> 17;
          const bf16_t* rp = proj + (size_t)(b * SEQ + t) * N1 + C_DAB;
          const float araw = bf2f(rp[dir * 8 + h]), braw = bf2f(rp[16 + dir * 8 + h]);
          const float A = -expf(dir ? p.a_log_b[h] : p.a_log_f[h]), dtb = dir ? p.dt_bias_b[h] : p.dt_bias_f[h];
          float Gc = A * softplus_f(araw + dtb);
#pragma unroll
          for (int o = 1; o < 32; o <<= 1) { const float nb = dir ? __shfl_down(Gc, o, 32) : __shfl_up(Gc, o, 32); const bool ok = dir ? ((lane & 31) + o < 32) : ((lane & 31) >= o); if (ok) Gc += nb; }
          gt[idx] = Gc; bt[idx] = 1.f / (1.f + expf(-braw)); } }
    LSTAMP(lds, 14);
    if (parts & 2) { bf16_t* eg = (bf16_t*)(p.ws + OFF_EG); float* dec = (float*)(p.ws + OFF_DEC);
      const int gw = blockIdx.x * NWAVES + wv, NGW = gridDim.x * NWAVES, hh = lane >> 5, r = lane & 31;
      const int combo = gw & 31, dir = combo >> 4, dtile = combo & 15, hd = dtile >> 2, dcol = dtile * 32 + r;
      const float* w2 = dir ? p.gla_w2_b : p.gla_w2_f; const float bias = (dir ? p.gla_b_b : p.gla_b_f)[dcol];
      bf16x8 bw; { u32x4 q;
#pragma unroll
          for (int e = 0; e < 4; ++e) q[e] = cvt2(w2[(8 * hh + 2 * e) * 512 + dcol], w2[(8 * hh + 2 * e + 1) * 512 + dcol]);
          bw = __builtin_bit_cast(bf16x8, q); }
      bf16x8 tri0, tri1; { u32x4 q0, q1;
#pragma unroll
          for (int e = 0; e < 4; ++e) { const int j0 = 2 * e, j1 = 2 * e + 1; const int s00 = 8 * (j0 >> 2) + 4 * hh + (j0 & 3), s01 = 8 * (j1 >> 2) + 4 * hh + (j1 & 3);
              q0[e] = (s00 <= r ? 0x3F80u : 0u) | ((s01 <= r ? 0x3F80u : 0u) << 16); q1[e] = (16 + s00 <= r ? 0x3F80u : 0u) | ((16 + s01 <= r ? 0x3F80u : 0u) << 16); }
          tri0 = __builtin_bit_cast(bf16x8, q0); tri1 = __builtin_bit_cast(bf16x8, q1); }
      for (int cg = gw >> 5; cg < NTOK / 32; cg += NGW >> 5) {
          const int b = cg >> 6, c = cg & 63; const size_t tok0 = (size_t)b * SEQ + c * 32;
          const int trow = dir ? 31 - r : r;
          const bf16x8 ag = *(const bf16x8*)(proj + (tok0 + trow) * N1 + C_GLR + dir * 16 + 8 * hh);
          f32x16 z = MFMA32(ag, bw, zero16());
          f32x16 la, lo;
#pragma unroll
          for (int i = 0; i < 16; ++i) { la[i] = log_sigmoid_f(z[i] + bias) * (1.f / 16.f); const float hi = bflo(cvt2(la[i], 0.f)); lo[i] = la[i] - hi; }
          f32x16 cum = MFMA32(tri0, pack8<0>(la), zero16()); cum = MFMA32(tri1, pack8<1>(la), cum); cum = MFMA32(tri0, pack8<0>(lo), cum); cum = MFMA32(tri1, pack8<1>(lo), cum);
          LAS unsigned short* st = (LAS unsigned short*)(lds + wv * 2048);
#pragma unroll
          for (int i = 0; i < 16; ++i) { const int row = crow(i, hh); const float E = __expf(cum[i]); st[(dir ? 31 - row : row) * 32 + r] = (unsigned short)(cvt2(E, 0.f) & 0xffffu);
              if (i == 15 && hh == 1) dec[((((size_t)dir * NB + b) * 4 + hd) * 64 + c) * 128 + (dtile & 3) * 32 + r] = E; }
          asm volatile("s_waitcnt lgkmcnt(0)" ::: "memory");
          bf16_t* ep = eg + ((size_t)dir * NTOK + tok0) * 512 + dtile * 32;
#pragma unroll
          for (int q = 0; q < 2; ++q) { const int row = (lane >> 2) + 16 * q, chn = lane & 3; *(u32x4*)(ep + (size_t)row * 512 + chn * 8) = *(const LAS u32x4*)(st + row * 32 + chn * 8); }
          asm volatile("s_waitcnt lgkmcnt(0)" ::: "memory");
      } }
    LSTAMP(lds, 15);
    if (parts & 4) for (int it = blockIdx.x; it < NB * 3 * 8; it += gridDim.x) { __syncthreads(); p1b_conv_item(p, it / 24, (it % 24) >> 3, it & 7, wv); }
}

__device__ __forceinline__ void load_prev(const bf16_t* ochunk  , unsigned loff  , bool second, u32x4 (&prev)[2]) {
    const u32x4* op = (const u32x4*)((const char*)ochunk + loff);
    if (second) { prev[0] = __builtin_nontemporal_load(op); prev[1] = __builtin_nontemporal_load(op + 1); }
    else { prev[0] = (u32x4){0u, 0u, 0u, 0u}; prev[1] = prev[0]; }
}
__device__ __forceinline__ void store_o(bf16_t* ochunk, unsigned loff, const f32x16& o, int lane, LAS float* scr, const u32x4 (&prev)[2], float* part = nullptr) {
    const int hh = lane >> 5, r = lane & 31;
#pragma unroll
    for (int reg = 0; reg < 16; ++reg) scr[crow(reg, hh) * 32 + r] = o[reg];
    asm volatile("s_waitcnt lgkmcnt(0)" ::: "memory");
    const LAS f32x4* sp = (const LAS f32x4*)(scr + (lane >> 1) * 32 + 16 * (lane & 1));
    const f32x4 a0 = sp[0], a1 = sp[1], a2 = sp[2], a3 = sp[3];
    u32x4 w0, w1;
    w0.x = cvt2(a0.x + bflo(prev[0].x), a0.y + bfhi(prev[0].x)); w0.y = cvt2(a0.z + bflo(prev[0].y), a0.w + bfhi(prev[0].y));
    w0.z = cvt2(a1.x + bflo(prev[0].z), a1.y + bfhi(prev[0].z)); w0.w = cvt2(a1.z + bflo(prev[0].w), a1.w + bfhi(prev[0].w));
    w1.x = cvt2(a2.x + bflo(prev[1].x), a2.y + bfhi(prev[1].x)); w1.y = cvt2(a2.z + bflo(prev[1].y), a2.w + bfhi(prev[1].y));
    w1.z = cvt2(a3.x + bflo(prev[1].z), a3.y + bfhi(prev[1].z)); w1.w = cvt2(a3.z + bflo(prev[1].w), a3.w + bfhi(prev[1].w));
    u32x4* op = (u32x4*)((char*)ochunk + loff);
    op[0] = w0; op[1] = w1;
    if (part) {
        float ss = 0.f;
#pragma unroll
        for (int e = 0; e < 4; ++e) { const float x0 = bflo(w0[e]), x1 = bfhi(w0[e]), x2 = bflo(w1[e]), x3 = bfhi(w1[e]); ss += (x0 * x0 + x1 * x1) + (x2 * x2 + x3 * x3); }
        ss += __shfl_xor(ss, 1);
        if (!(lane & 1)) *(float*)((char*)part + (loff >> 11) * 256) = ss;
    }
    asm volatile("s_waitcnt lgkmcnt(0)" ::: "memory");
}
__device__ __forceinline__ void rowvals16(const LAS float* tab, int hh, int z, float (&out)[16]) {
#pragma unroll
    for (int g = 0; g < 4; ++g) { const f32x4 v = *(const LAS f32x4*)(tab + z + 8 * g + 4 * hh);
#pragma unroll
        for (int e = 0; e < 4; ++e) out[4 * g + e] = v[e]; }
}
__device__ __forceinline__ void glds16_asm(const void* gsrc, unsigned lds_dst) {
    unsigned keep;
    asm volatile("s_mov_b32 %0, m0\n\ts_mov_b32 m0, %2\n\ts_nop 0\n\tglobal_load_lds_dwordx4 %1, off\n\ts_mov_b32 m0, %0" : "=&s"(keep) : "v"(gsrc), "s"(lds_dst) : "memory");
}
__device__ __forceinline__ unsigned lds_addr(const LAS unsigned char* p) { return (unsigned)__builtin_amdgcn_readfirstlane((int)(unsigned)(size_t)p); }
#define SCHED_FENCE() __builtin_amdgcn_sched_barrier(0)
#define LAUNDER(v) asm volatile("" : "+v"(v))

constexpr int GLA_BUF = 3 * 8192 + 512, GLA_DIR = 2 * GLA_BUF, SCR_OFF = 110592;
__device__ __forceinline__ void p2_gla_chunked(const Params& p, int b, int h, int half, LAS unsigned char* lds, int wv) {
    const int tid = TID(wv), lane = tid & 63, wave = wv, dir = wave >> 2, ct = wave & 3, hh = lane >> 5, r = lane & 31, dtid = tid & 255;
    LAS unsigned char* dbase = lds + dir * GLA_DIR; LAS float* scr = (LAS float*)(lds + SCR_OFF + 4096 * wave);
    const bf16_t* proj = (const bf16_t*)(p.ws + OFF_PROJ); const bf16_t* eg = (const bf16_t*)(p.ws + OFF_EG) + (size_t)dir * NTOK * 512;
    const float* dect = (const float*)(p.ws + OFF_DEC) + (((size_t)dir * NB + b) * 4 + h) * 64 * 128;
    bf16_t* ocol = (bf16_t*)p.out + (size_t)b * SEQ * D + h * 256 + half * 128 + ct * 32;
    const unsigned o_loff = (unsigned)((dir ? 31 - (lane >> 1) : (lane >> 1)) * D * 2 + 32 * (lane & 1));
    unsigned p_loff[2], e_loff[2];
#pragma unroll
    for (int j = 0; j < 2; ++j) { const int id = dtid + 256 * j, row = id >> 4, ch = id & 15, tl = dir ? 31 - row : row; p_loff[j] = (unsigned)(tl * N1 * 2 + ch * 16); e_loff[j] = (unsigned)(tl * 1024 + ch * 16); }
    unsigned v_loff[2];
#pragma unroll
    for (int jj = 0; jj < 2; ++jj) { const int blk = ct + 4 * jj, row = 4 * blk + (lane >> 4), ch = (lane & 15) ^ (((row & 3) << 2) | ((row >> 2) & 3)), tl = dir ? 31 - row : row; v_loff[jj] = (unsigned)(tl * N1 * 2 + ch * 16); }
    u32x4 rq[2], rk[2], re[2]; float rdec = 0.f;
    auto dma_v = [&](int n, int bi) {
        const int c = dir ? 63 - n : n; const char* vb = (const char*)(proj + ((size_t)b * SEQ + c * 32) * N1 + C_GV + h * 256 + half * 128);
#pragma unroll
        for (int jj = 0; jj < 2; ++jj) glds16_asm(vb + v_loff[jj], lds_addr(dbase + bi * GLA_BUF + 16384 + (ct + 4 * jj) * 1024));
    };
    auto issue = [&](int n) {
        const int c = dir ? 63 - n : n; const char* rb = (const char*)(proj + ((size_t)b * SEQ + c * 32) * N1 + h * 128); const char* eb = (const char*)(eg + ((size_t)b * SEQ + c * 32) * 512 + h * 128);
#pragma unroll
        for (int j = 0; j < 2; ++j) { rq[j] = *(const u32x4*)(rb + C_GQ * 2 + p_loff[j]); rk[j] = *(const u32x4*)(rb + C_GK * 2 + p_loff[j]); re[j] = *(const u32x4*)(eb + e_loff[j]); }
        if (dtid < 128) rdec = dect[c * 128 + dtid];
    };
    auto commit = [&](int bi) {
        LAS unsigned char* bb = dbase + bi * GLA_BUF;
#pragma unroll
        for (int j = 0; j < 2; ++j) { const int id = dtid + 256 * j, row = id >> 4, ch = id & 15; const unsigned o = offb(row, ch);
            u32x4 qd, ki;
#pragma unroll
            for (int e = 0; e < 4; ++e) { const float e0 = bflo(re[j][e]), e1 = bfhi(re[j][e]);
                qd[e] = cvt2(bflo(rq[j][e]) * e0 * 0.08838834764831845f, bfhi(rq[j][e]) * e1 * 0.08838834764831845f);
                ki[e] = cvt2(bflo(rk[j][e]) * __builtin_amdgcn_rcpf(e0), bfhi(rk[j][e]) * __builtin_amdgcn_rcpf(e1)); }
            *(LAS u32x4*)(bb + o) = qd; *(LAS u32x4*)(bb + 8192 + o) = ki; }
        if (dtid < 128) *(LAS float*)(bb + 24576 + dtid * 4) = rdec;
    };
    f32x16 S[4];
#pragma unroll
    for (int i = 0; i < 4; ++i) S[i] = zero16();
    __syncthreads();
    issue(0); dma_v(0, 0); commit(0);
    asm volatile("s_waitcnt vmcnt(0)" ::: "memory");
    __syncthreads();
    for (int n = 0; n < 64; ++n) {
        const LAS unsigned char* QD = dbase + (n & 1) * GLA_BUF; const LAS unsigned char* KI = QD + 8192; const LAS unsigned char* VV = QD + 16384; const LAS float* DEC = (const LAS float*)(QD + 24576);
        const int c = dir ? 63 - n : n; bf16_t* ochunk = ocol + (size_t)c * 32 * D;
        if (n + 1 < 64) { issue(n + 1); dma_v(n + 1, (n + 1) & 1); }
        f32x16 sc = zero16();
        int l1 = lane; LAUNDER(l1);
#pragma unroll
        for (int ks = 0; ks < 4; ++ks) sc = MFMA32(rowfrag_nat(KI, ks, l1), rowfrag_nat(QD, ks, l1), sc);
        SCHED_FENCE();
#pragma unroll
        for (int ks = 4; ks < 8; ++ks) sc = MFMA32(rowfrag_nat(KI, ks, l1), rowfrag_nat(QD, ks, l1), sc);
#pragma unroll
        for (int reg = 0; reg < 16; ++reg) if (crow(reg, hh) > r) sc[reg] = 0.f;
        SCHED_FENCE();
        u32x4 prev[2]; load_prev(ochunk, o_loff, n >= 32, prev);
        int l2 = lane; LAUNDER(l2);
        const bf16x8 vt0 = trfrag_perm(VV, ct, 0, l2), vt1 = trfrag_perm(VV, ct, 1, l2);
        f32x16 o = zero16();
        o = MFMA32(pack8<0>(sc), vt0, o); o = MFMA32(pack8<1>(sc), vt1, o);
#pragma unroll
        for (int dt = 0; dt < 2; ++dt) { o = MFMA32(rowfrag_perm(QD, 2 * dt, l2), pack8<0>(S[dt]), o); o = MFMA32(rowfrag_perm(QD, 2 * dt + 1, l2), pack8<1>(S[dt]), o); }
        SCHED_FENCE();
#pragma unroll
        for (int dt = 2; dt < 4; ++dt) { o = MFMA32(rowfrag_perm(QD, 2 * dt, l2), pack8<0>(S[dt]), o); o = MFMA32(rowfrag_perm(QD, 2 * dt + 1, l2), pack8<1>(S[dt]), o); }
        SCHED_FENCE();
        int l3 = lane; LAUNDER(l3);
#pragma unroll
        for (int dt = 0; dt < 4; ++dt) { f32x16 ds = S[dt];
            ds = MFMA32(trfrag_perm(KI, dt, 0, l3), vt0, ds); ds = MFMA32(trfrag_perm(KI, dt, 1, l3), vt1, ds);
#pragma unroll
            for (int g = 0; g < 4; ++g) { const f32x4 dv = *(const LAS f32x4*)(DEC + 32 * dt + 8 * g + 4 * hh);
#pragma unroll
                for (int e = 0; e < 4; ++e) ds[4 * g + e] *= dv[e]; }
            S[dt] = ds; }
        SCHED_FENCE();
        store_o(ochunk, o_loff, o, lane, scr, prev);
        if (n + 1 < 64) commit((n + 1) & 1);
        asm volatile("s_waitcnt vmcnt(0)" ::: "memory");
        __syncthreads();
    }
}

constexpr int GDN_BUF = 3 * 8192 + 256, GDN_DIR = 2 * GDN_BUF + 4096;
__device__ __forceinline__ void p2_gdn_chunked(const Params& p, int b, int h, LAS unsigned char* lds, int wv) {
    const int tid = TID(wv), lane = tid & 63, wave = wv, dir = wave >> 2, ct = wave & 3, hh = lane >> 5, r = lane & 31, dtid = tid & 255;
    LAS unsigned char* dbase = lds + dir * GDN_DIR; LAS unsigned char* TF = dbase + 2 * GDN_BUF; LAS float* scr = (LAS float*)(lds + SCR_OFF + 4096 * wave);
    const bf16_t* proj = (const bf16_t*)(p.ws + OFF_PROJ);
    const float* gtab = (const float*)(p.ws + OFF_GT) + (((size_t)dir * NB + b) * 8 + h) * SEQ; const float* btab = (const float*)(p.ws + OFF_BT) + (((size_t)dir * NB + b) * 8 + h) * SEQ;
    bf16_t* ocol = (bf16_t*)p.out + (size_t)NTOK * D + (size_t)b * SEQ * D + h * 128 + ct * 32;
    const unsigned o_loff = (unsigned)((dir ? 31 - (lane >> 1) : (lane >> 1)) * D * 2 + 32 * (lane & 1));
    unsigned d_loff[2];
#pragma unroll
    for (int jj = 0; jj < 2; ++jj) { const int blk = ct + 4 * jj, row = 4 * blk + (lane >> 4), ch = (lane & 15) ^ (((row & 3) << 2) | ((row >> 2) & 3)), tl = dir ? 31 - row : row; d_loff[jj] = (unsigned)(tl * N1 * 2 + ch * 16); }
    const unsigned g_loff = (unsigned)((dir ? 31 - (dtid & 31) : (dtid & 31)) * 4);
    float rg = 0.f;
    auto dma = [&](int n, int bi) {
        const int c = dir ? 63 - n : n; const char* rb = (const char*)(proj + ((size_t)b * SEQ + c * 32) * N1 + h * 128);
#pragma unroll
        for (int tile = 0; tile < 3; ++tile)
#pragma unroll
            for (int jj = 0; jj < 2; ++jj)
                glds16_asm(rb + (tile == 0 ? C_DK : tile == 1 ? C_DQ : C_DV) * 2 + d_loff[jj], lds_addr(dbase + bi * GDN_BUF + tile * 8192 + (ct + 4 * jj) * 1024));
    };
    auto issue_g = [&](int n) { const int c = dir ? 63 - n : n; if (dtid < 64) rg = *(const float*)((const char*)((dtid < 32 ? gtab : btab) + c * 32) + g_loff); };
    auto commit_g = [&](int bi) { if (dtid < 64) *(LAS float*)(dbase + bi * GDN_BUF + 24576 + dtid * 4) = rg; };
    f32x16 S[4];
#pragma unroll
    for (int i = 0; i < 4; ++i) S[i] = zero16();
    __syncthreads();
    dma(0, 0); issue_g(0); commit_g(0);
    asm volatile("s_waitcnt vmcnt(0)" ::: "memory");
    __syncthreads();
    for (int n = 0; n < 64; ++n) {
        const LAS unsigned char* KN = dbase + (n & 1) * GDN_BUF; const LAS unsigned char* QN = KN + 8192; const LAS unsigned char* VV = KN + 16384; const LAS float* GS = (const LAS float*)(KN + 24576); const LAS float* BS = GS + 32;
        const int c = dir ? 63 - n : n; bf16_t* ochunk = ocol + (size_t)c * 32 * D;
        if (n + 1 < 64) dma(n + 1, (n + 1) & 1);
        bf16x8 at0, at1; f32x16 o;
        {
            const float Gc = GS[r];
            if (ct == dir) {
                f32x16 kk = zero16();
                int l0 = lane; LAUNDER(l0);
#pragma unroll
                for (int ks = 0; ks < 8; ++ks) { const bf16x8 f = rowfrag_nat(KN, ks, l0); kk = MFMA32(f, f, kk); }
                f32x16 X, Xt, Pt;
                { float Ga[16], Ba[16]; const float Bc = BS[r]; int z0 = 0; LAUNDER(z0); rowvals16(GS, hh, z0, Ga); rowvals16(BS, hh, z0, Ba);
#pragma unroll
                  for (int reg = 0; reg < 16; ++reg) { const int a = crow(reg, hh);
                      X[reg] = (r < a) ? -Ba[reg] * kk[reg] * __expf(Ga[reg] - Gc) : 0.f;
                      Xt[reg] = (a < r) ? -Bc * kk[reg] * __expf(Gc - Ga[reg]) : 0.f;
                      Pt[reg] = Xt[reg] + (a == r ? 1.f : 0.f); } }
#pragma unroll
                for (int lvl = 0; lvl < 4; ++lvl) {
                    const bf16x8 x0 = pack8<0>(X), x1 = pack8<1>(X), xt0 = pack8<0>(Xt), xt1 = pack8<1>(Xt);
                    f32x16 Xn = MFMA32(xt0, x0, zero16()); Xn = MFMA32(xt1, x1, Xn);
                    if (lvl < 3) { f32x16 Xtn = MFMA32(x0, xt0, zero16()); Xtn = MFMA32(x1, xt1, Xtn); Xt = Xtn; }
                    X = Xn;
                    const bf16x8 n0 = pack8<0>(X), n1 = pack8<1>(X), p0 = pack8<0>(Pt), p1 = pack8<1>(Pt);
                    Pt = MFMA32(n0, p0, Pt); Pt = MFMA32(n1, p1, Pt);
                }
                { float Ga[16], Ba[16]; int z1 = 0; LAUNDER(z1); rowvals16(GS, hh, z1, Ga); rowvals16(BS, hh, z1, Ba);
                  f32x16 T1, T2;
#pragma unroll
                  for (int reg = 0; reg < 16; ++reg) { T2[reg] = Pt[reg] * Ba[reg]; T1[reg] = -T2[reg] * __expf(Ga[reg]); }
                  *(LAS bf16x8*)(TF + 0 * 1024 + lane * 16) = pack8<0>(T1); *(LAS bf16x8*)(TF + 1 * 1024 + lane * 16) = pack8<1>(T1);
                  *(LAS bf16x8*)(TF + 2 * 1024 + lane * 16) = pack8<0>(T2); *(LAS bf16x8*)(TF + 3 * 1024 + lane * 16) = pack8<1>(T2); }
            }
            SCHED_FENCE();
            float Ga[16]; { int z2 = 0; LAUNDER(z2); rowvals16(GS, hh, z2, Ga); }
            f32x16 at = zero16();
            int l1 = lane; LAUNDER(l1);
#pragma unroll
            for (int ks = 0; ks < 4; ++ks) at = MFMA32(rowfrag_nat(KN, ks, l1), rowfrag_nat(QN, ks, l1), at);
            SCHED_FENCE();
#pragma unroll
            for (int ks = 4; ks < 8; ++ks) at = MFMA32(rowfrag_nat(KN, ks, l1), rowfrag_nat(QN, ks, l1), at);
#pragma unroll
            for (int reg = 0; reg < 16; ++reg) at[reg] = (crow(reg, hh) <= r) ? at[reg] * __expf(Gc - Ga[reg]) : 0.f;
            at0 = pack8<0>(at); at1 = pack8<1>(at);
            SCHED_FENCE();
            o = zero16();
            int l2 = lane; LAUNDER(l2);
#pragma unroll
            for (int dt = 0; dt < 2; ++dt) { o = MFMA32(rowfrag_perm(QN, 2 * dt, l2), pack8<0>(S[dt]), o); o = MFMA32(rowfrag_perm(QN, 2 * dt + 1, l2), pack8<1>(S[dt]), o); }
            SCHED_FENCE();
#pragma unroll
            for (int dt = 2; dt < 4; ++dt) { o = MFMA32(rowfrag_perm(QN, 2 * dt, l2), pack8<0>(S[dt]), o); o = MFMA32(rowfrag_perm(QN, 2 * dt + 1, l2), pack8<1>(S[dt]), o); }
#pragma unroll
            for (int reg = 0; reg < 16; ++reg) o[reg] *= __expf(Ga[reg]);
        }
        __syncthreads();
        u32x4 prev[2]; load_prev(ochunk, o_loff, n >= 32, prev);
        if (n + 1 < 64) issue_g(n + 1);
        {
            const bf16x8 tf0 = *(const LAS bf16x8*)(TF + 0 * 1024 + lane * 16), tf1 = *(const LAS bf16x8*)(TF + 1 * 1024 + lane * 16);
            const bf16x8 tf2 = *(const LAS bf16x8*)(TF + 2 * 1024 + lane * 16), tf3 = *(const LAS bf16x8*)(TF + 3 * 1024 + lane * 16);
            int l3 = lane; LAUNDER(l3);
            const bf16x8 vt0 = trfrag_perm(VV, ct, 0, l3), vt1 = trfrag_perm(VV, ct, 1, l3);
            f32x16 vn = MFMA32(tf2, vt0, zero16()); vn = MFMA32(tf3, vt1, vn);
#pragma unroll
            for (int dt = 0; dt < 4; ++dt) {
                f32x16 w = MFMA32(trfrag_perm(KN, dt, 0, l3), tf0, zero16()); w = MFMA32(trfrag_perm(KN, dt, 1, l3), tf1, w);
                vn = MFMA32(pack8<0>(w), pack8<0>(S[dt]), vn); vn = MFMA32(pack8<1>(w), pack8<1>(S[dt]), vn);
            }
            o = MFMA32(at0, pack8<0>(vn), o); o = MFMA32(at1, pack8<1>(vn), o);
            SCHED_FENCE();
            const float Glast = GS[31]; const float decl = __expf(Glast);
#pragma unroll
            for (int g = 0; g < 4; ++g) { const f32x4 gv = *(const LAS f32x4*)(GS + 8 * g + 4 * hh);
#pragma unroll
                for (int e = 0; e < 4; ++e) vn[4 * g + e] *= __expf(Glast - gv[e]); }
            const bf16x8 vn0 = pack8<0>(vn), vn1 = pack8<1>(vn);
            int l4 = lane; LAUNDER(l4);
#pragma unroll
            for (int dt = 0; dt < 4; ++dt) { f32x16 ds = S[dt];
#pragma unroll
                for (int reg = 0; reg < 16; ++reg) ds[reg] *= decl;
                ds = MFMA32(trfrag_perm(KN, dt, 0, l4), vn0, ds); ds = MFMA32(trfrag_perm(KN, dt, 1, l4), vn1, ds); S[dt] = ds; }
        }
        SCHED_FENCE();
        store_o(ochunk, o_loff, o, lane, scr, prev);
        if (n + 1 < 64) commit_g((n + 1) & 1);
        asm volatile("s_waitcnt vmcnt(0)" ::: "memory");
        __syncthreads();
    }
}

__device__ __forceinline__ unsigned off128(unsigned row, unsigned ch) { return 128u * row + 16u * (ch ^ (((row >> 1) & 1u) << 2)); }
__device__ __forceinline__ bf16x8 trfrag_perm128(const LAS unsigned char* img, int ct, int ks, int lane) {
    const unsigned h = lane >> 5, blk = (lane >> 4) & 1, q = (lane & 15) >> 2, pp = lane & 3;
    const unsigned a0 = off128(16 * ks + 4 * h + q, 4 * ct + 2 * blk + (pp >> 1)) + 8 * (pp & 1), a1 = off128(16 * ks + 4 * h + 8 + q, 4 * ct + 2 * blk + (pp >> 1)) + 8 * (pp & 1);
    const s16x4 lo = __builtin_amdgcn_ds_read_tr16_b64_v4i16((LAS s16x4*)(img + a0)), hi = __builtin_amdgcn_ds_read_tr16_b64_v4i16((LAS s16x4*)(img + a1));
    return __builtin_shufflevector(lo, hi, 0, 1, 2, 3, 4, 5, 6, 7);
}
constexpr int PS_SCR = 140800;

constexpr int GLA2_QD = 0, GLA2_KI = 24576, GLA2_VV = 49152, GLA2_DEC = 57344, GLA2_PF = 58880, GLA2_DIR = 62976;
__device__ __forceinline__ void p2_gla_ps(const Params& p, int b, int h, int quarter, LAS unsigned char* lds, int wv) {
    const int tid = TID(wv), lane = tid & 63, wave = wv, hh = lane >> 5, r = lane & 31, dtid = tid & 255, ldir = tid >> 8;
    const bf16_t* proj = (const bf16_t*)(p.ws + OFF_PROJ);
    LAS unsigned char* lbase = lds + ldir * GLA2_DIR;
    const bf16_t* eg = (const bf16_t*)(p.ws + OFF_EG) + (size_t)ldir * NTOK * 512;
    const float* dect = (const float*)(p.ws + OFF_DEC) + (((size_t)ldir * NB + b) * 4 + h) * 64 * 128;
    unsigned p_loff[2], e_loff[2];
#pragma unroll
    for (int j = 0; j < 2; ++j) { const int id = dtid + 256 * j, row = id >> 4, ch = id & 15, tl = ldir ? 31 - row : row; p_loff[j] = (unsigned)(tl * N1 * 2 + ch * 16); e_loff[j] = (unsigned)(tl * 1024 + ch * 16); }
    const int vdir = wave >> 2, vpc = wave & 3;
    unsigned v_loff; { const int row = 8 * vpc + (lane >> 3), ch = (lane & 7) ^ (((row >> 1) & 1) << 2), tl = vdir ? 31 - row : row; v_loff = (unsigned)(tl * N1 * 2 + ch * 16); }
    u32x4 rq[2], rk[2], re[2]; float rdec = 0.f;
    auto chunk_of = [&](int d, int n) { return d ? 63 - n : n; };
    auto dma_v = [&](int n) { const int c = chunk_of(vdir, n); const char* vb = (const char*)(proj + ((size_t)b * SEQ + c * 32) * N1 + C_GV + h * 256 + quarter * 64);
        glds16_asm(vb + v_loff, lds_addr(lds + vdir * GLA2_DIR + GLA2_VV + (n & 1) * 4096 + vpc * 1024)); };
    auto issue = [&](int n) { const int c = chunk_of(ldir, n); const char* rb = (const char*)(proj + ((size_t)b * SEQ + c * 32) * N1 + h * 128); const char* eb = (const char*)(eg + ((size_t)b * SEQ + c * 32) * 512 + h * 128);
#pragma unroll
        for (int j = 0; j < 2; ++j) { rq[j] = *(const u32x4*)(rb + C_GQ * 2 + p_loff[j]); rk[j] = *(const u32x4*)(rb + C_GK * 2 + p_loff[j]); re[j] = *(const u32x4*)(eb + e_loff[j]); }
        if (dtid < 128) rdec = dect[c * 128 + dtid]; };
    auto commit = [&](int n) { LAS unsigned char* bb = lbase + (n % 3) * 8192;
#pragma unroll
        for (int j = 0; j < 2; ++j) { const int id = dtid + 256 * j, row = id >> 4, ch = id & 15; const unsigned o = offb(row, ch);
            u32x4 qd, ki;
#pragma unroll
            for (int e = 0; e < 4; ++e) { const float e0 = bflo(re[j][e]), e1 = bfhi(re[j][e]);
                qd[e] = cvt2(bflo(rq[j][e]) * e0 * 0.08838834764831845f, bfhi(rq[j][e]) * e1 * 0.08838834764831845f);
                ki[e] = cvt2(bflo(rk[j][e]) * __builtin_amdgcn_rcpf(e0), bfhi(rk[j][e]) * __builtin_amdgcn_rcpf(e1)); }
            *(LAS u32x4*)(bb + GLA2_QD + o) = qd; *(LAS u32x4*)(bb + GLA2_KI + o) = ki; }
        if (dtid < 128) *(LAS float*)(lbase + GLA2_DEC + (n % 3) * 512 + dtid * 4) = rdec; };
    auto prep = [&](int dir, int n) {
        const LAS unsigned char* QD = lds + dir * GLA2_DIR + GLA2_QD + (n % 3) * 8192; const LAS unsigned char* KI = lds + dir * GLA2_DIR + GLA2_KI + (n % 3) * 8192;
        LAS unsigned char* PF = lds + dir * GLA2_DIR + GLA2_PF + (n & 1) * 2048;
        f32x16 sc = zero16(); int l1 = lane; LAUNDER(l1);
#pragma unroll
        for (int ks = 0; ks < 8; ++ks) sc = MFMA32(rowfrag_nat(KI, ks, l1), rowfrag_nat(QD, ks, l1), sc);
#pragma unroll
        for (int reg = 0; reg < 16; ++reg) if (crow(reg, hh) > r) sc[reg] = 0.f;
        *(LAS bf16x8*)(PF + lane * 16) = pack8<0>(sc); *(LAS bf16x8*)(PF + 1024 + lane * 16) = pack8<1>(sc);
    };
    __syncthreads();
    issue(0); commit(0); issue(1); commit(1); if (true) { dma_v(0); }
    asm volatile("s_waitcnt vmcnt(0)" ::: "memory");
    __syncthreads();
    if (wave == 4 || wave == 5) prep(wave - 4, 0);
    __syncthreads();
    if (wave < 4) {
        const int dir = wave >> 1, ct = wave & 1;
        LAS unsigned char* dbase = lds + dir * GLA2_DIR; LAS float* scr = (LAS float*)(lds + PS_SCR + 4096 * wave);
        bf16_t* ocol = (bf16_t*)p.out + (size_t)b * SEQ * D + h * 256 + quarter * 64 + ct * 32;
        const unsigned o_loff = (unsigned)((dir ? 31 - (lane >> 1) : (lane >> 1)) * D * 2 + 32 * (lane & 1));
        f32x16 S[4];
#pragma unroll
        for (int i = 0; i < 4; ++i) S[i] = zero16();
        for (int n = 0; n < 64; ++n) {
            if (n + 2 < 64) issue(n + 2);
            if (n + 1 < 64) dma_v(n + 1);
            const LAS unsigned char* QD = dbase + GLA2_QD + (n % 3) * 8192; const LAS unsigned char* KI = dbase + GLA2_KI + (n % 3) * 8192; const LAS unsigned char* VV = dbase + GLA2_VV + (n & 1) * 4096;
            const LAS float* DEC = (const LAS float*)(dbase + GLA2_DEC + (n % 3) * 512); const LAS unsigned char* PF = dbase + GLA2_PF + (n & 1) * 2048;
            bf16_t* ochunk = ocol + (size_t)chunk_of(dir, n) * 32 * D;
            u32x4 prev[2]; load_prev(ochunk, o_loff, n >= 32, prev);
            int l2 = lane; LAUNDER(l2);
            const bf16x8 vt0 = trfrag_perm128(VV, ct, 0, l2), vt1 = trfrag_perm128(VV, ct, 1, l2);
            f32x16 o = MFMA32(*(const LAS bf16x8*)(PF + lane * 16), vt0, zero16()); o = MFMA32(*(const LAS bf16x8*)(PF + 1024 + lane * 16), vt1, o);
#pragma unroll
            for (int dt = 0; dt < 2; ++dt) { o = MFMA32(rowfrag_perm(QD, 2 * dt, l2), pack8<0>(S[dt]), o); o = MFMA32(rowfrag_perm(QD, 2 * dt + 1, l2), pack8<1>(S[dt]), o); }
            SCHED_FENCE();
#pragma unroll
            for (int dt = 2; dt < 4; ++dt) { o = MFMA32(rowfrag_perm(QD, 2 * dt, l2), pack8<0>(S[dt]), o); o = MFMA32(rowfrag_perm(QD, 2 * dt + 1, l2), pack8<1>(S[dt]), o); }
            SCHED_FENCE();
            int l3 = lane; LAUNDER(l3);
#pragma unroll
            for (int dt = 0; dt < 4; ++dt) { f32x16 ds = S[dt];
                ds = MFMA32(trfrag_perm(KI, dt, 0, l3), vt0, ds); ds = MFMA32(trfrag_perm(KI, dt, 1, l3), vt1, ds);
#pragma unroll
                for (int g = 0; g < 4; ++g) { const f32x4 dv = *(const LAS f32x4*)(DEC + 32 * dt + 8 * g + 4 * hh);
#pragma unroll
                    for (int e = 0; e < 4; ++e) ds[4 * g + e] *= dv[e]; }
                S[dt] = ds; }
            SCHED_FENCE();
            store_o(ochunk, o_loff, o, lane, scr, prev, n >= 32 ? (float*)(p.ws + OFF_PART) + ((size_t)b * SEQ + chunk_of(dir, n) * 32) * 64 + h * 8 + quarter * 2 + ct : nullptr);
            if (n + 2 < 64) commit(n + 2);
            asm volatile("s_waitcnt vmcnt(0)" ::: "memory");
            __syncthreads();
        }
    } else {
        for (int n = 0; n < 64; ++n) {
            if (n + 2 < 64) issue(n + 2);
            if (n + 1 < 64) dma_v(n + 1);
            if (wave < 6 && n + 1 < 64) prep(wave - 4, n + 1);
            if (n + 2 < 64) commit(n + 2);
            asm volatile("s_waitcnt vmcnt(0)" ::: "memory");
            __syncthreads();
        }
    }
}

constexpr int GDN2_KN = 0, GDN2_QN = 24576, GDN2_VV = 49152, GDN2_GB = 57344, GDN2_PF = 58112, GDN2_DIR = 70400;
__device__ __forceinline__ void p2_gdn_ps(const Params& p, int b, int h, int half, LAS unsigned char* lds, int wv) {
    const int tid = TID(wv), lane = tid & 63, wave = wv, hh = lane >> 5, r = lane & 31;
    const bf16_t* proj = (const bf16_t*)(p.ws + OFF_PROJ);
    auto chunk_of = [&](int d, int n) { return d ? 63 - n : n; };
    unsigned pc_loff[5];
#pragma unroll
    for (int j = 0; j < 5; ++j) { const int id = wave + 8 * j, pd = id / 20, q = id % 20;
        if (q < 16) { const int blk = q & 7, row = 4 * blk + (lane >> 4), ch = (lane & 15) ^ (((row & 3) << 2) | ((row >> 2) & 3)), tl = pd ? 31 - row : row; pc_loff[j] = (unsigned)(tl * N1 * 2 + ch * 16); }
        else { const int v = q - 16, row = 8 * v + (lane >> 3), ch = (lane & 7) ^ (((row >> 1) & 1) << 2), tl = pd ? 31 - row : row; pc_loff[j] = (unsigned)(tl * N1 * 2 + ch * 16); } }
    auto dma = [&](int n) {
#pragma unroll
        for (int j = 0; j < 5; ++j) { const int id = wave + 8 * j, pd = id / 20, q = id % 20;
            if (q < 16) { if (n + 2 < 64) { const int c = chunk_of(pd, n + 2); const char* rb = (const char*)(proj + ((size_t)b * SEQ + c * 32) * N1 + h * 128 + (q < 8 ? C_DK : C_DQ));
                    glds16_asm(rb + pc_loff[j], lds_addr(lds + pd * GDN2_DIR + (q < 8 ? GDN2_KN : GDN2_QN) + ((n + 2) % 3) * 8192 + (q & 7) * 1024)); } }
            else { if (n + 1 >= 0 && n + 1 < 64) { const int c = chunk_of(pd, n + 1); const char* rb = (const char*)(proj + ((size_t)b * SEQ + c * 32) * N1 + C_DV + h * 128 + half * 64);
                    glds16_asm(rb + pc_loff[j], lds_addr(lds + pd * GDN2_DIR + GDN2_VV + ((n + 1) & 1) * 4096 + (q - 16) * 1024)); } } }
    };
    const int gdir = (tid >> 6) & 1, gsel = (tid >> 5) & 1;
    const float* gsrc = (const float*)(p.ws + (gsel ? OFF_BT : OFF_GT)) + (((size_t)gdir * NB + b) * 8 + h) * SEQ;
    const unsigned g_loff = (unsigned)((gdir ? 31 - (tid & 31) : (tid & 31)) * 4);
    float rg = 0.f;
    auto issue_g = [&](int n) { if (tid < 128) rg = *(const float*)((const char*)(gsrc + chunk_of(gdir, n) * 32) + g_loff); };
    auto commit_g = [&](int n) { if (tid < 128) *(LAS float*)(lds + gdir * GDN2_DIR + GDN2_GB + (n % 3) * 256 + gsel * 128 + (tid & 31) * 4) = rg; };
    auto prepA = [&](int dir, int n) {
        const LAS unsigned char* KN = lds + dir * GDN2_DIR + GDN2_KN + (n % 3) * 8192; const LAS float* GS = (const LAS float*)(lds + dir * GDN2_DIR + GDN2_GB + (n % 3) * 256); const LAS float* BS = GS + 32;
        LAS unsigned char* PF = lds + dir * GDN2_DIR + GDN2_PF + (n & 1) * 6144;
        const float Gc = GS[r];
        f32x16 kk = zero16(); int l0 = lane; LAUNDER(l0);
#pragma unroll
        for (int ks = 0; ks < 8; ++ks) { const bf16x8 f = rowfrag_nat(KN, ks, l0); kk = MFMA32(f, f, kk); }
        f32x16 X, Xt, Pt;
        { float Ga[16], Ba[16]; const float Bc = BS[r]; int z0 = 0; LAUNDER(z0); rowvals16(GS, hh, z0, Ga); rowvals16(BS, hh, z0, Ba);
#pragma unroll
          for (int reg = 0; reg < 16; ++reg) { const int a = crow(reg, hh);
              X[reg] = (r < a) ? -Ba[reg] * kk[reg] * __expf(Ga[reg] - Gc) : 0.f;
              Xt[reg] = (a < r) ? -Bc * kk[reg] * __expf(Gc - Ga[reg]) : 0.f;
              Pt[reg] = Xt[reg] + (a == r ? 1.f : 0.f); } }
#pragma unroll
        for (int lvl = 0; lvl < 4; ++lvl) {
            const bf16x8 x0 = pack8<0>(X), x1 = pack8<1>(X), xt0 = pack8<0>(Xt), xt1 = pack8<1>(Xt);
            f32x16 Xn = MFMA32(xt0, x0, zero16()); Xn = MFMA32(xt1, x1, Xn);
            if (lvl < 3) { f32x16 Xtn = MFMA32(x0, xt0, zero16()); Xtn = MFMA32(x1, xt1, Xtn); Xt = Xtn; }
            X = Xn;
            const bf16x8 n0 = pack8<0>(X), n1 = pack8<1>(X), p0 = pack8<0>(Pt), p1 = pack8<1>(Pt);
            Pt = MFMA32(n0, p0, Pt); Pt = MFMA32(n1, p1, Pt);
        }
        { float Ga[16], Ba[16]; int z1 = 0; LAUNDER(z1); rowvals16(GS, hh, z1, Ga); rowvals16(BS, hh, z1, Ba);
          f32x16 T1, T2;
#pragma unroll
          for (int reg = 0; reg < 16; ++reg) { T2[reg] = Pt[reg] * Ba[reg]; T1[reg] = -T2[reg] * __expf(Ga[reg]); }
          *(LAS bf16x8*)(PF + 0 * 1024 + lane * 16) = pack8<0>(T1); *(LAS bf16x8*)(PF + 1 * 1024 + lane * 16) = pack8<1>(T1);
          *(LAS bf16x8*)(PF + 2 * 1024 + lane * 16) = pack8<0>(T2); *(LAS bf16x8*)(PF + 3 * 1024 + lane * 16) = pack8<1>(T2); }
    };
    auto prepB = [&](int dir, int n) {
        const LAS unsigned char* KN = lds + dir * GDN2_DIR + GDN2_KN + (n % 3) * 8192; const LAS unsigned char* QN = lds + dir * GDN2_DIR + GDN2_QN + (n % 3) * 8192;
        const LAS float* GS = (const LAS float*)(lds + dir * GDN2_DIR + GDN2_GB + (n % 3) * 256); LAS unsigned char* PF = lds + dir * GDN2_DIR + GDN2_PF + (n & 1) * 6144;
        const float Gc = GS[r]; float Ga[16]; { int z2 = 0; LAUNDER(z2); rowvals16(GS, hh, z2, Ga); }
        f32x16 at = zero16(); int l1 = lane; LAUNDER(l1);
#pragma unroll
        for (int ks = 0; ks < 8; ++ks) at = MFMA32(rowfrag_nat(KN, ks, l1), rowfrag_nat(QN, ks, l1), at);
#pragma unroll
        for (int reg = 0; reg < 16; ++reg) at[reg] = (crow(reg, hh) <= r) ? at[reg] * __expf(Gc - Ga[reg]) : 0.f;
        *(LAS bf16x8*)(PF + 4 * 1024 + lane * 16) = pack8<0>(at); *(LAS bf16x8*)(PF + 5 * 1024 + lane * 16) = pack8<1>(at);
    };
    __syncthreads();
    dma(-2); dma(-1); issue_g(0); commit_g(0); issue_g(1); commit_g(1);
    asm volatile("s_waitcnt vmcnt(0)" ::: "memory");
    __syncthreads();
    if (wave == 4 || wave == 5) prepA(wave - 4, 0); else if (wave >= 6) prepB(wave - 6, 0);
    __syncthreads();
    if (wave < 4) {
        const int dir = wave >> 1, ct = wave & 1;
        LAS unsigned char* dbase = lds + dir * GDN2_DIR; LAS float* scr = (LAS float*)(lds + PS_SCR + 4096 * wave);
        bf16_t* ocol = (bf16_t*)p.out + (size_t)NTOK * D + (size_t)b * SEQ * D + h * 128 + half * 64 + ct * 32;
        const unsigned o_loff = (unsigned)((dir ? 31 - (lane >> 1) : (lane >> 1)) * D * 2 + 32 * (lane & 1));
        f32x16 S[4];
#pragma unroll
        for (int i = 0; i < 4; ++i) S[i] = zero16();
        for (int n = 0; n < 64; ++n) {
            dma(n); if (n + 2 < 64) issue_g(n + 2);
            const LAS unsigned char* KN = dbase + GDN2_KN + (n % 3) * 8192; const LAS unsigned char* QN = dbase + GDN2_QN + (n % 3) * 8192; const LAS unsigned char* VV = dbase + GDN2_VV + (n & 1) * 4096;
            const LAS float* GS = (const LAS float*)(dbase + GDN2_GB + (n % 3) * 256); const LAS unsigned char* PF = dbase + GDN2_PF + (n & 1) * 6144;
            bf16_t* ochunk = ocol + (size_t)chunk_of(dir, n) * 32 * D;
            u32x4 prev[2]; load_prev(ochunk, o_loff, n >= 32, prev);
            f32x16 o = zero16(); int l2 = lane; LAUNDER(l2);
#pragma unroll
            for (int dt = 0; dt < 2; ++dt) { o = MFMA32(rowfrag_perm(QN, 2 * dt, l2), pack8<0>(S[dt]), o); o = MFMA32(rowfrag_perm(QN, 2 * dt + 1, l2), pack8<1>(S[dt]), o); }
            SCHED_FENCE();
#pragma unroll
            for (int dt = 2; dt < 4; ++dt) { o = MFMA32(rowfrag_perm(QN, 2 * dt, l2), pack8<0>(S[dt]), o); o = MFMA32(rowfrag_perm(QN, 2 * dt + 1, l2), pack8<1>(S[dt]), o); }
            { float Ga[16]; int z2 = 0; LAUNDER(z2); rowvals16(GS, hh, z2, Ga);
#pragma unroll
              for (int reg = 0; reg < 16; ++reg) o[reg] *= __expf(Ga[reg]); }
            SCHED_FENCE();
            const bf16x8 tf0 = *(const LAS bf16x8*)(PF + 0 * 1024 + lane * 16), tf1 = *(const LAS bf16x8*)(PF + 1 * 1024 + lane * 16);
            const bf16x8 tf2 = *(const LAS bf16x8*)(PF + 2 * 1024 + lane * 16), tf3 = *(const LAS bf16x8*)(PF + 3 * 1024 + lane * 16);
            int l3 = lane; LAUNDER(l3);
            const bf16x8 vt0 = trfrag_perm128(VV, ct, 0, l3), vt1 = trfrag_perm128(VV, ct, 1, l3);
            f32x16 vn = MFMA32(tf2, vt0, zero16()); vn = MFMA32(tf3, vt1, vn);
#pragma unroll
            for (int dt = 0; dt < 4; ++dt) {
                f32x16 w = MFMA32(trfrag_perm(KN, dt, 0, l3), tf0, zero16()); w = MFMA32(trfrag_perm(KN, dt, 1, l3), tf1, w);
                vn = MFMA32(pack8<0>(w), pack8<0>(S[dt]), vn); vn = MFMA32(pack8<1>(w), pack8<1>(S[dt]), vn);
            }
            o = MFMA32(*(const LAS bf16x8*)(PF + 4 * 1024 + lane * 16), pack8<0>(vn), o); o = MFMA32(*(const LAS bf16x8*)(PF + 5 * 1024 + lane * 16), pack8<1>(vn), o);
            SCHED_FENCE();
            const float Glast = GS[31]; const float decl = __expf(Glast);
#pragma unroll
            for (int g = 0; g < 4; ++g) { const f32x4 gv = *(const LAS f32x4*)(GS + 8 * g + 4 * hh);
#pragma unroll
                for (int e = 0; e < 4; ++e) vn[4 * g + e] *= __expf(Glast - gv[e]); }
            const bf16x8 vn0 = pack8<0>(vn), vn1 = pack8<1>(vn);
            int l4 = lane; LAUNDER(l4);
#pragma unroll
            for (int dt = 0; dt < 4; ++dt) { f32x16 ds = S[dt];
#pragma unroll
                for (int reg = 0; reg < 16; ++reg) ds[reg] *= decl;
                ds = MFMA32(trfrag_perm(KN, dt, 0, l4), vn0, ds); ds = MFMA32(trfrag_perm(KN, dt, 1, l4), vn1, ds); S[dt] = ds; }
            SCHED_FENCE();
            store_o(ochunk, o_loff, o, lane, scr, prev, n >= 32 ? (float*)(p.ws + OFF_PART) + ((size_t)b * SEQ + chunk_of(dir, n) * 32) * 64 + 32 + h * 4 + half * 2 + ct : nullptr);
            if (n + 2 < 64) commit_g(n + 2);
            asm volatile("s_waitcnt vmcnt(0)" ::: "memory");
            __syncthreads();
        }
    } else {
        for (int n = 0; n < 64; ++n) {
            dma(n); if (n + 2 < 64) issue_g(n + 2);
            if (n + 1 < 64) { if (wave < 6) prepA(wave - 4, n + 1); else prepB(wave - 6, n + 1); }
            if (n + 2 < 64) commit_g(n + 2);
            asm volatile("s_waitcnt vmcnt(0)" ::: "memory");
            __syncthreads();
        }
    }
}

__device__ __forceinline__ void p2c_headnorm(const Params& p, int wv) {
    const int tid = TID(wv), lane = tid & 63, wave = wv;
    const int gw = blockIdx.x * NWAVES + wave, NGW = gridDim.x * NWAVES;
    bf16_t* oa = (bf16_t*)p.out; bf16_t* ob = oa + (size_t)NTOK * D;
    for (int m = gw; m < NTOK; m += NGW) {
#pragma unroll
        for (int hd = 0; hd < 4; ++hd) { u32x2* op = (u32x2*)(oa + (size_t)m * D + hd * 256) + lane; const u32x2 w = *op;
            const float v0 = bflo(w.x), v1 = bfhi(w.x), v2 = bflo(w.y), v3 = bfhi(w.y);
            const float rstd = rsqrtf(wave_sum((v0 * v0 + v1 * v1) + (v2 * v2 + v3 * v3)) * (1.f / 256.f) + EPS);
            const f32x4 g = *(const f32x4*)(p.gla_norm_w + lane * 4);
            u32x2 o; o.x = pk2(v0 * rstd * g.x, v1 * rstd * g.y); o.y = pk2(v2 * rstd * g.z, v3 * rstd * g.w); *op = o; }
#pragma unroll
        for (int hd = 0; hd < 8; ++hd) { unsigned* op = (unsigned*)(ob + (size_t)m * D + hd * 128) + lane; const unsigned w = *op;
            const float v0 = bflo(w), v1 = bfhi(w);
            const float rstd = rsqrtf(wave_sum(v0 * v0 + v1 * v1) * (1.f / 128.f) + EPS);
            const f32x2 g = *(const f32x2*)(p.gdn_norm_w + lane * 2);
            *op = pk2(v0 * rstd * g.x, v1 * rstd * g.y); }
    }
}

__device__ __forceinline__ void p2_gla_item(const Params& p, int b, int h, LAS float* sm, int wv) {
    const int tid = TID(wv), j = tid & 255, pp = tid >> 8, lane = tid & 63, wave = wv;
    LAS float* s_q = sm; LAS float* s_k = sm + 128; LAS float* s_a = sm + 256; LAS float* s_glr = sm + 384; LAS float* s_b = sm + 400; LAS float* s_w2 = sm + 528; LAS float* s_op = sm + 528 + 2048;
    const bf16_t* proj = (const bf16_t*)(p.ws + OFF_PROJ); bf16_t* og = (bf16_t*)p.out;
    for (int dir = 0; dir < 2; ++dir) {
        const float* w2 = dir ? p.gla_w2_b : p.gla_w2_f; const float* bb = dir ? p.gla_b_b : p.gla_b_f;
        __syncthreads();
        for (int i = tid; i < 2048; i += NTHR) { const int r = i >> 7, d = i & 127; s_w2[i] = w2[r * 512 + h * 128 + d]; }
        if (tid < 128) s_b[tid] = bb[h * 128 + tid];
        float S[64];
#pragma unroll
        for (int i = 0; i < 64; ++i) S[i] = 0.f;
        unsigned short nq = 0, nk = 0, ng = 0, nv = 0;
        { const bf16_t* rp = proj + (size_t)(b * SEQ + (dir ? SEQ - 1 : 0)) * N1;
          if (tid < 128) { nq = rp[C_GQ + h * 128 + tid]; nk = rp[C_GK + h * 128 + tid]; } else if (tid < 144) ng = rp[C_GLR + dir * 16 + tid - 128];
          nv = rp[C_GV + h * 256 + j]; }
        for (int step = 0; step < SEQ; ++step) {
            const int t = dir ? SEQ - 1 - step : step; const size_t row = (size_t)b * SEQ + t;
            if (tid < 128) { s_q[tid] = bf2f(nq) * 0.08838834764831845f; s_k[tid] = bf2f(nk); } else if (tid < 144) s_glr[tid - 128] = bf2f(ng);
            const float v = bf2f(nv);
            if (step + 1 < SEQ) { const bf16_t* rp = proj + (size_t)(b * SEQ + (dir ? t - 1 : t + 1)) * N1;
                if (tid < 128) { nq = rp[C_GQ + h * 128 + tid]; nk = rp[C_GK + h * 128 + tid]; } else if (tid < 144) ng = rp[C_GLR + dir * 16 + tid - 128];
                nv = rp[C_GV + h * 256 + j]; }
            __syncthreads();
            if (tid < 128) { float z = s_b[tid];
#pragma unroll
                for (int r = 0; r < 16; ++r) z += s_glr[r] * s_w2[r * 128 + tid];
                s_a[tid] = expf(log_sigmoid_f(z) * (1.f / 16.f)); }
            __syncthreads();
            float o = 0.f;
#pragma unroll
            for (int dd = 0; dd < 64; ++dd) { const int d = 64 * pp + dd; S[dd] = s_a[d] * S[dd] + s_k[d] * v; o += s_q[d] * S[dd]; }
            s_op[pp * 256 + j] = o;
            __syncthreads();
            if (pp == 0) { float ot = s_op[j] + s_op[256 + j]; bf16_t* op = og + row * D + h * 256 + j; if (dir) ot += bf2f(*op); *op = (bf16_t)f2bf(ot); }
        }
    }
}

__device__ __forceinline__ void p2_gdn_item(const Params& p, int b, int h, LAS float* sm, int wv) {
    const int tid = TID(wv), j = tid & 127, pp = tid >> 7;
    LAS float* s_c = sm;
    LAS float* s_sc = sm + 384;
    LAS float* s_p1 = sm + 392;
    LAS float* s_p2 = sm + 392 + 512;
    const bf16_t* proj = (const bf16_t*)(p.ws + OFF_PROJ); bf16_t* og = (bf16_t*)p.out + (size_t)NTOK * D;
    const int col = C_DQ + (tid >> 7) * 1024 + h * 128 + (tid & 127);
    for (int dir = 0; dir < 2; ++dir) {
        const float* gtab = (const float*)(p.ws + OFF_GT) + (((size_t)dir * NB + b) * 8 + h) * SEQ; const float* btab = (const float*)(p.ws + OFF_BT) + (((size_t)dir * NB + b) * 8 + h) * SEQ;
        float S[32];
#pragma unroll
        for (int i = 0; i < 32; ++i) S[i] = 0.f;
        __syncthreads();
        for (int step = 0; step < SEQ; ++step) {
            const int t = dir ? SEQ - 1 - step : step; const size_t row = (size_t)b * SEQ + t;
            if (tid < 384) s_c[tid] = bf2f(proj[row * N1 + col]);
            else if (tid == 384) { const float g = gtab[t]; const float gp = (step & 31) ? gtab[dir ? t + 1 : t - 1] : 0.f; s_sc[0] = expf(g - gp); s_sc[1] = btab[t]; }
            __syncthreads();
            const float alpha = s_sc[0], beta = s_sc[1];
            float pred = 0.f;
#pragma unroll
            for (int dd = 0; dd < 32; ++dd) { const int d = 32 * pp + dd; S[dd] *= alpha; pred += s_c[128 + d] * S[dd]; }
            s_p1[pp * 128 + j] = pred;
            __syncthreads();
            const float predt = (s_p1[j] + s_p1[128 + j]) + (s_p1[256 + j] + s_p1[384 + j]);
            const float delta = beta * (s_c[256 + j] - predt);
            float o = 0.f;
#pragma unroll
            for (int dd = 0; dd < 32; ++dd) { const int d = 32 * pp + dd; S[dd] += s_c[128 + d] * delta; o += s_c[d] * S[dd]; }
            s_p2[pp * 128 + j] = o;
            __syncthreads();
            if (pp == 0) { float ot = (s_p2[j] + s_p2[128 + j]) + (s_p2[256 + j] + s_p2[384 + j]); bf16_t* op = og + row * D + h * 128 + j; if (dir) ot += bf2f(*op); *op = (bf16_t)f2bf(ot); }
        }
    }
}

#ifndef SCAN_PS
#define SCAN_PS 1
#endif
#ifndef SCAN_GLA_CHUNKED
#define SCAN_GLA_CHUNKED 1
#endif
#ifndef SCAN_GDN_CHUNKED
#define SCAN_GDN_CHUNKED 1
#endif
__device__ __forceinline__ void p2_scans(const Params& p, LAS unsigned char* lds, int wv, int mask = 3) {
    if constexpr (SCAN_PS) {
        for (int it = blockIdx.x; it < 256; it += gridDim.x) {
            const int lo3 = it & 7, mid = (it >> 3) & 3, hi = it >> 5;
            if (hi < 4) { const int bh = hi * 8 + lo3; if (mask & 1) p2_gla_ps(p, bh >> 2, bh & 3, mid, lds, wv); }
            else { const int q = (hi - 4) * 16 + (mid >> 1) * 8 + lo3; if (mask & 2) p2_gdn_ps(p, q >> 3, q & 7, mid & 1, lds, wv); }
        }
        return;
    }
    LAS float* sm = (LAS float*)lds;
    constexpr int NGLA = SCAN_GLA_CHUNKED ? 64 : 32;
    for (int it = blockIdx.x; it < NGLA + 64; it += gridDim.x) {
        __syncthreads();
        if (it < NGLA ? !(mask & 1) : !(mask & 2)) continue;
        if (it < NGLA) { if constexpr (SCAN_GLA_CHUNKED) p2_gla_chunked(p, it >> 3, (it >> 1) & 3, it & 1, lds, wv); else p2_gla_item(p, it >> 2, it & 3, sm, wv); }
        else { const int q = it - NGLA; if constexpr (SCAN_GDN_CHUNKED) p2_gdn_chunked(p, q >> 3, q & 7, lds, wv); else p2_gdn_item(p, q >> 3, q & 7, sm, wv); }
    }
}

__device__ __forceinline__ void p5_router(const Params& p, LAS unsigned char* lds, int wv, int parts = 3) {
    const int tid = TID(wv), lane = tid & 63, wave = wv;
    const int gw = blockIdx.x * NWAVES + wave, NGW = gridDim.x * NWAVES;
    if (parts & 1) { LAS float* scr = (LAS float*)(lds + wave * 8448);
      bf16_t* wgu = (bf16_t*)(p.ws + OFF_WGU); bf16_t* wd = (bf16_t*)(p.ws + OFF_WD);
      for (int it = gw; it < NEXP * 384; it += NGW) {
          const int e = it / 384, r = it % 384;
          if (r < 128) { const int kb = r >> 3, nb = r & 7; transpose_item(p.w_gate + (size_t)e * D * DEXP, DEXP, kb * 64, nb * 32, p.norm2_w, scr, lane, GuRow{wgu + (size_t)e * 512 * D, 0}); }
          else if (r < 256) { const int q = r - 128, kb = q >> 3, nb = q & 7; transpose_item(p.w_up + (size_t)e * D * DEXP, DEXP, kb * 64, nb * 32, p.norm2_w, scr, lane, GuRow{wgu + (size_t)e * 512 * D, 1}); }
          else { const int q = r - 256, kb = q >> 5, nb = q & 31; transpose_item(p.w_down + (size_t)e * DEXP * D, D, kb * 64, nb * 32, nullptr, scr, lane, PlainRow{wd + (size_t)e * D * DEXP, DEXP}); }
      } }
    __syncthreads();
    LSTAMP(lds, 12);
    if (!(parts & 2)) return;
    LAS float* part = (LAS float*)lds;
    LAS float* s_rstd = part + 8 * 64 * 37;
    const float* x1 = (const float*)(p.ws + OFF_X1); bf16_t* h2 = (bf16_t*)(p.ws + OFF_MIX);
    unsigned* cnt = (unsigned*)(p.ws + OFF_CTL); int* lslot = (int*)(p.ws + OFF_LSLOT); float* lw = (float*)(p.ws + OFF_LW);
    for (int blk = blockIdx.x; blk < NTOK / 64; blk += gridDim.x) {
        LAS float* wsl = (LAS float*)(lds + wave * 18432);
        { const int k0 = wave * 128;
#pragma unroll
          for (int i = 0; i < 16; ++i) { const int idx = i * 64 + lane, kk = idx >> 3, c4 = idx & 7; const f32x4 v = *(const f32x4*)(p.w_router + (size_t)(k0 + kk) * 32 + 4 * c4); const float g = p.norm2_w[k0 + kk];
              LAS float* d = wsl + kk * 36 + 4 + 4 * c4; d[0] = v.x * g; d[1] = v.y * g; d[2] = v.z * g; d[3] = v.w * g; }
#pragma unroll
          for (int i = 0; i < 2; ++i) { const int kk = i * 64 + lane; const f32x4 v = *(const f32x4*)(p.w_group + (size_t)(k0 + kk) * 4); const float g = p.norm2_w[k0 + kk];
              LAS float* d = wsl + kk * 36; d[0] = v.x * g; d[1] = v.y * g; d[2] = v.z * g; d[3] = v.w * g; }
          LDS_WAIT(); }
        const int tok = blk * 64 + lane;
        float acc[36]; float ss = 0.f;
#pragma unroll
        for (int i = 0; i < 36; ++i) acc[i] = 0.f;
        const float* xr = x1 + (size_t)tok * D + wave * 128;
#pragma unroll 2
        for (int kk = 0; kk < 128; kk += 4) {
            const f32x4 xv = *(const f32x4*)(xr + kk);
            ss += (xv.x * xv.x + xv.y * xv.y) + (xv.z * xv.z + xv.w * xv.w);
#pragma unroll
            for (int i = 0; i < 4; ++i) { const LAS f32x4* wr4 = (const LAS f32x4*)(wsl + (kk + i) * 36);
#pragma unroll
                for (int q = 0; q < 9; ++q) { const f32x4 w = wr4[q]; acc[4 * q] += xv[i] * w.x; acc[4 * q + 1] += xv[i] * w.y; acc[4 * q + 2] += xv[i] * w.z; acc[4 * q + 3] += xv[i] * w.w; } }
        }
        __syncthreads();
#pragma unroll
        for (int i = 0; i < 36; ++i) part[(wave * 64 + lane) * 37 + i] = acc[i];
        part[(wave * 64 + lane) * 37 + 36] = ss;
        __syncthreads();
        if (wave == 0) {
            float l[36]; float st = 0.f;
#pragma unroll
            for (int i = 0; i < 36; ++i) l[i] = 0.f;
#pragma unroll 1
            for (int w = 0; w < 8; ++w) {
#pragma unroll
                for (int i = 0; i < 36; ++i) l[i] += part[(w * 64 + lane) * 37 + i];
                st += part[(w * 64 + lane) * 37 + 36]; }
            const float rstd = rsqrtf(st * (1.f / D) + EPS);
            s_rstd[lane] = rstd;
#pragma unroll
            for (int i = 0; i < 36; ++i) l[i] *= rstd;
            int gi = 0; float gm = l[0];
#pragma unroll
            for (int i = 1; i < 4; ++i) if (l[i] > gm) { gm = l[i]; gi = i; }
            float gs = 0.f;
#pragma unroll
            for (int i = 0; i < 4; ++i) gs += expf(l[i] - gm);
            const float group_w = 1.f / gs;
            float el[8];
#pragma unroll
            for (int i = 0; i < 8; ++i) el[i] = gi == 0 ? l[4 + i] : gi == 1 ? l[12 + i] : gi == 2 ? l[20 + i] : l[28 + i];
            int i1 = 0; float m1 = el[0];
#pragma unroll
            for (int i = 1; i < 8; ++i) if (el[i] > m1) { m1 = el[i]; i1 = i; }
            int i2 = -1; float m2 = -3.0e38f;
#pragma unroll
            for (int i = 0; i < 8; ++i) if (i != i1 && el[i] > m2) { m2 = el[i]; i2 = i; }
            const float e2 = expf(m2 - m1);
            const float w1 = group_w / (1.f + e2), w2 = group_w * e2 / (1.f + e2);
            const int ea = gi * 8 + i1, eb = gi * 8 + i2;
            unsigned na = 0, nb = 0, ra = 0, rb = 0;
            const unsigned long long lt = (1ull << lane) - 1ull;
#pragma unroll 4
            for (int e = 0; e < NEXP; ++e) { const unsigned long long m1 = __ballot(ea == e), m2 = __ballot(eb == e);
                if (lane == e) { na = (unsigned)__popcll(m1); nb = (unsigned)__popcll(m2); }
                if (ea == e) ra = (unsigned)__popcll(m1 & lt);
                if (eb == e) rb = (unsigned)__popcll(m2 & lt); }
            unsigned base = 0;
            if (lane < NEXP && na + nb) base = atomicAdd(&cnt[lane * 64], na + nb);
            const unsigned pa = (unsigned)__shfl((int)base, ea) + ra, pb = (unsigned)__shfl((int)base, eb) + (unsigned)__shfl((int)na, eb) + rb;
            lslot[ea * LISTCAP + pa] = tok * 2; lw[ea * LISTCAP + pa] = w1;
            lslot[eb * LISTCAP + pb] = tok * 2 + 1; lw[eb * LISTCAP + pb] = w2;
        }
        __syncthreads();
#pragma unroll
        for (int r = 0; r < 8; ++r) {
            const int row = blk * 64 + wave * 8 + r; const float rs = s_rstd[wave * 8 + r];
            const f32x4* xq = (const f32x4*)(x1 + (size_t)row * D) + lane; u32x2* o8 = (u32x2*)(h2 + (size_t)row * D) + lane;
#pragma unroll
            for (int jj = 0; jj < 4; ++jj) { const f32x4 v = xq[64 * jj]; u32x2 w; w.x = pg8::cvt_pk_bf16(v.x * rs, v.y * rs); w.y = pg8::cvt_pk_bf16(v.z * rs, v.w * rs); o8[64 * jj] = w; }
        }
        __syncthreads();
    }
}

constexpr int MOE_TAB_OFF = 131072;
__device__ __forceinline__ void moe_unit_tables(const Params& p, LAS unsigned char* lds, int wv, pg8::MoeSched& S, int npn) {
    LAS int* tabE = (LAS int*)(lds + MOE_TAB_OFF); LAS int* tabLB = tabE + 192; LAS int* tabCnt = tabLB + 192; LAS int* tabN = tabCnt + 32;
    const unsigned* cnt = (const unsigned*)(p.ws + OFF_CTL);
    __syncthreads();
    if (TID(wv) == 0) { int u = 0;
        for (int e = 0; e < NEXP; ++e) { const int c = (int)cnt[e * 64]; tabCnt[e] = c; const int nb = (c + 255) >> 8; for (int lb = 0; lb < nb; ++lb) { tabE[u] = e; tabLB[u] = lb; ++u; } }
        tabN[0] = u; }
    __syncthreads();
    S.tabE = tabE; S.tabLB = tabLB; S.tabCnt = tabCnt; S.NU = tabN[0]; S.NPN = npn; S.G = gridDim.x; S.c = blockIdx.x;
}
__device__ __forceinline__ void p6_expert_up(const Params& p, LAS unsigned char* lds, int wv) {
    pg8::MoeSched S; moe_unit_tables(p, lds, wv, S, 2);
    pg8::EpiSwiGLU E{(bf16_t*)(p.ws + OFF_HID)};
    pg8::gemm_phase_moe<pg8::EpiSwiGLU, true>(lds, (const bf16_t*)(p.ws + OFF_MIX), (const bf16_t*)(p.ws + OFF_WGU), D, 512, S, E, (const int*)(p.ws + OFF_LSLOT), wv);
}
__device__ __forceinline__ void p7_expert_down(const Params& p, LAS unsigned char* lds, int wv) {
    pg8::MoeSched S; moe_unit_tables(p, lds, wv, S, 4);
    pg8::EpiScatter E{(bf16_t*)(p.ws + OFF_YB), (const int*)(p.ws + OFF_LSLOT), (const float*)(p.ws + OFF_LW)};
    pg8::gemm_phase_moe<pg8::EpiScatter, false>(lds, (const bf16_t*)(p.ws + OFF_HID), (const bf16_t*)(p.ws + OFF_WD), DEXP, D, S, E, (const int*)(p.ws + OFF_LSLOT), wv);
}

__device__ __forceinline__ void p8_final(const Params& p, int wv) {
    const int tid = TID(wv), lane = tid & 63, wave = wv;
    const int gw = blockIdx.x * NWAVES + wave, NGW = gridDim.x * NWAVES;
    const float* x1 = (const float*)(p.ws + OFF_X1); const bf16_t* yb = (const bf16_t*)(p.ws + OFF_YB);
    for (int m = gw; m < NTOK; m += NGW) {
        const f32x4* xr = (const f32x4*)(x1 + (size_t)m * D) + lane;
        const u32x2* y0 = (const u32x2*)(yb + (size_t)(2 * m) * D) + lane; const u32x2* y1 = (const u32x2*)(yb + (size_t)(2 * m + 1) * D) + lane;
        f32x4 v[4]; float s = 0.f;
#pragma unroll
        for (int j = 0; j < 4; ++j) { v[j] = xr[64 * j]; const u32x2 a = y0[64 * j], b = y1[64 * j];
            v[j].x += bflo(a.x) + bflo(b.x); v[j].y += bfhi(a.x) + bfhi(b.x); v[j].z += bflo(a.y) + bflo(b.y); v[j].w += bfhi(a.y) + bfhi(b.y);
            s += (v[j].x * v[j].x + v[j].y * v[j].y) + (v[j].z * v[j].z + v[j].w * v[j].w); }
        const float rstd = rsqrtf(wave_sum(s) * (1.f / D) + EPS);
        f32x4* o = (f32x4*)(p.out + (size_t)m * D) + lane;
#pragma unroll
        for (int j = 0; j < 4; ++j) { const f32x4 g = *((const f32x4*)p.norm_f_w + lane + 64 * j); o[64 * j] = (f32x4){v[j].x * rstd * g.x, v[j].y * rstd * g.y, v[j].z * rstd * g.z, v[j].w * rstd * g.w}; }
    }
}


#define XB_TMO      128
#define XB_XCNT(j)  (256  + 64 * (j))
#define XB_XSUB(j)  (1280 + 64 * (j))
#define XB_XGEN(j)  (2304 + 64 * (j))
#define XB_TOP      3328
#define XB_TOPGEN   3392
#define XCD_BAR_WORDS 3456
#define XB_SPIN_CAP (1u << 22)
__device__ __forceinline__ unsigned xb_ld(unsigned* p)              { return __hip_atomic_load(p, __ATOMIC_RELAXED, __HIP_MEMORY_SCOPE_AGENT); }
__device__ __forceinline__ unsigned xb_add(unsigned* p, unsigned v) { return __hip_atomic_fetch_add(p, v, __ATOMIC_RELAXED, __HIP_MEMORY_SCOPE_AGENT); }
__device__ __forceinline__ unsigned xb_xcc_id() { return (unsigned)__builtin_amdgcn_s_getreg((3 << 11) | 20) & 0xFu; }
#define XB_SPIN(cond, bar) do { unsigned _sp = 0; while (cond) { __builtin_amdgcn_s_sleep(1); \
    if ((++_sp & 255u) == 0u) { if (xb_ld(&(bar)[XB_TMO])) break; if (_sp > XB_SPIN_CAP) { atomicAdd(&(bar)[XB_TMO], 1u); break; } } } } while (0)
struct XcdBarrier { unsigned* bar; unsigned x; volatile LAS unsigned* st; };
__device__ __forceinline__ XcdBarrier xcd_barrier_post(unsigned* bar, volatile LAS unsigned* st, bool leader) {
    XcdBarrier b; b.bar = bar; b.x = xb_xcc_id(); b.st = st;
    if (leader) (void)xb_add(&bar[XB_XCNT(b.x)], 1u);
    return b;
}
__device__ __forceinline__ void xcd_barrier_complete(unsigned* bar, unsigned x, unsigned& nloc, unsigned& nx) {
    const unsigned G = gridDim.x * gridDim.y * gridDim.z;
    unsigned sum, cnt, mine, sp = 0u;
    for (;;) {
        sum = 0u; cnt = 0u; mine = 0u;
#pragma unroll
        for (unsigned j = 0; j < 16; ++j) { const unsigned c = xb_ld(&bar[XB_XCNT(j)]); sum += c; cnt += (c > 0u) ? 1u : 0u; mine = (j == x) ? c : mine; }
        if (sum == G) break;
        __builtin_amdgcn_s_sleep(1);
        if ((++sp & 255u) == 0u) { if (xb_ld(&bar[XB_TMO])) break; if (sp > XB_SPIN_CAP) { atomicAdd(&bar[XB_TMO], 1u); break; } }
    }
    nloc = mine > 0u ? mine : 1u; nx = cnt > 0u ? cnt : 1u;
}
__device__ __forceinline__ void xcd_barrier(const XcdBarrier& b, bool leader) {
    asm volatile("s_waitcnt vmcnt(0)" ::: "memory");
    __syncthreads();
    if (leader) {
        unsigned* bar = b.bar;
        __builtin_amdgcn_s_waitcnt(0);
        unsigned nloc = b.st[0], nx = b.st[1];
        if (nloc == 0u) { xcd_barrier_complete(bar, b.x, nloc, nx); b.st[0] = nloc; b.st[1] = nx; }
        const unsigned old = xb_add(&bar[XB_XSUB(b.x)], 1u);
        const unsigned gen = old / nloc;
        if (old + 1u == (gen + 1u) * nloc) {
            __builtin_amdgcn_fence(__ATOMIC_RELEASE, "agent");
            asm volatile("s_waitcnt vmcnt(0)" ::: "memory");
            const unsigned og = xb_add(&bar[XB_TOP], 1u);
            const unsigned tg = og / nx;
            if (og + 1u == (tg + 1u) * nx) xb_add(&bar[XB_TOPGEN], 1u);
            else XB_SPIN(xb_ld(&bar[XB_TOPGEN]) == tg, bar);
            __builtin_amdgcn_fence(__ATOMIC_ACQUIRE, "agent");
            xb_add(&bar[XB_XGEN(b.x)], 1u);
            asm volatile("s_waitcnt vmcnt(0)" ::: "memory");
        } else {
            XB_SPIN(xb_ld(&bar[XB_XGEN(b.x)]) == gen, bar);
            __builtin_amdgcn_fence(__ATOMIC_ACQUIRE, "agent");
            asm volatile("s_waitcnt vmcnt(0)" ::: "memory");
        }
    }
    __syncthreads();
}
constexpr size_t CTL_BAR = 16384;

constexpr int NPHASES = 9;
#ifndef ONLY_PHASE
#define ONLY_PHASE -1
#endif
#define PH_ON(k) (ONLY_PHASE < 0 || ONLY_PHASE == (k))
__global__ void __launch_bounds__(NTHR, 2) fwd_megakernel(Params p) {
    extern __shared__ __attribute__((aligned(16))) unsigned char lds_raw[];
    LAS unsigned char* lds = (LAS unsigned char*)lds_raw;
    const int G = gridDim.x;
    const int wv = __builtin_amdgcn_readfirstlane((int)threadIdx.x >> 6);
    const bool leader = threadIdx.x == 0;
    volatile LAS unsigned* xst = (volatile LAS unsigned*)(lds + LDS_BYTES - 16);
    if (leader) { xst[0] = 0u; xst[1] = 0u; }
    __syncthreads();
    const XcdBarrier xbar = xcd_barrier_post((unsigned*)(p.ws + OFF_CTL + CTL_BAR), xst, leader);
    volatile LAS unsigned long long* stamps = (volatile LAS unsigned long long*)(lds + LDS_BYTES - 256);
    int nstamp = 0;
#define STAMP() do { if ((SPIN_K >= 0 || SPIN_A >= 0) && blockIdx.x == 0 && threadIdx.x == 0) stamps[nstamp] = __builtin_amdgcn_s_memrealtime(); ++nstamp; } while (0)
    STAMP();
#define GRID_SYNC() do { xcd_barrier(xbar, TID(wv) == 0); STAMP(); } while (0)
    const int lo = p.ph_lo, hi = p.ph_hi;
#ifndef REPEAT_PHASE
#define REPEAT_PHASE -1
#endif
#define IN(k) (PH_ON(k) && lo <= (k) && (k) < hi)
#define REP(k, stmt) do { if (REPEAT_PHASE == (k)) { GRID_SYNC(); stmt; } } while (0)
#define SEAM(k) do { if ((k) + 1 < hi && lo <= (k)) GRID_SYNC(); } while (0)
    if (IN(0)) p0_prologue(p, lds, wv);
    REP(0, p0_prologue(p, lds, wv));
    SEAM(0);
    if (IN(1)) { pg8::Gemm g{(const bf16_t*)(p.ws + OFF_XN), (const bf16_t*)(p.ws + OFF_WT1), NTOK, N1, D}; pg8::StaticOrder S; S.init(NTOK, N1, G, (int)blockIdx.x);
                 pg8::EpiBf16 E{(bf16_t*)(p.ws + OFF_PROJ), N1}; pg8::gemm_phase(lds, g, S, E, wv); REP(1, pg8::gemm_phase(lds, g, S, E, wv)); }
    if (IN(1)) { GRID_SYNC(); p1b_prepass(p, lds, wv); }
    REP(10, p1b_prepass(p, lds, wv, 1));
    REP(11, p1b_prepass(p, lds, wv, 2));
    if (REPEAT_PHASE == 9) { for (int q = 0; q < 10; ++q) GRID_SYNC(); }
    SEAM(1);
    if (IN(2)) p2_scans(p, lds, wv);
    REP(2, p2_scans(p, lds, wv));
    REP(20, p2_scans(p, lds, wv, 1));
    REP(21, p2_scans(p, lds, wv, 2));
    if (IN(2) && !SCAN_PS) { GRID_SYNC(); p2c_headnorm(p, wv); }
    SEAM(2);
    if (IN(3)) { pg8::Gemm g{(const bf16_t*)(p.ws + OFF_XN), (const bf16_t*)(p.ws + OFF_WT3), NTOK, 4096, D}; pg8::StaticOrder S; S.init(NTOK, 4096, G, (int)blockIdx.x);
                 pg8::EpiMix E{(const bf16_t*)p.out, (const bf16_t*)p.out + (size_t)NTOK * D, (bf16_t*)(p.ws + OFF_MIX), (const float*)(p.ws + OFF_PART), p.gla_norm_w, p.gdn_norm_w}; pg8::gemm_phase(lds, g, S, E, wv); REP(3, pg8::gemm_phase(lds, g, S, E, wv)); }
    SEAM(3);
    if (IN(4)) { pg8::Gemm g{(const bf16_t*)(p.ws + OFF_MIX), (const bf16_t*)(p.ws + OFF_WTO), NTOK, D, D}; pg8::StaticOrder S; S.init(NTOK, D, G, (int)blockIdx.x);
                 pg8::EpiRes E{p.x, (float*)(p.ws + OFF_X1), D}; pg8::gemm_phase(lds, g, S, E, wv); REP(4, pg8::gemm_phase(lds, g, S, E, wv)); }
    SEAM(4);
    if (IN(5)) p5_router(p, lds, wv);
    REP(12, p5_router(p, lds, wv, 1));
    SEAM(5);
    if (IN(6)) p6_expert_up(p, lds, wv);
    REP(6, p6_expert_up(p, lds, wv));
    SEAM(6);
    if (IN(7)) p7_expert_down(p, lds, wv);
    REP(7, p7_expert_down(p, lds, wv));
    SEAM(7);
    if (IN(8)) p8_final(p, wv);
    REP(8, p8_final(p, wv));
    STAMP();
    if ((SPIN_K >= 0 || SPIN_A >= 0) && blockIdx.x == 0 && threadIdx.x == 0) { const unsigned long long dt = SPIN_A >= 0 ? stamps[SPIN_B] - stamps[SPIN_A] : stamps[SPIN_K + 1] - stamps[SPIN_K], t0 = __builtin_amdgcn_s_memrealtime();
        while (__builtin_amdgcn_s_memrealtime() - t0 < 9ull * dt) __builtin_amdgcn_s_sleep(8); }
#undef IN
#undef SEAM
#undef GRID_SYNC
}

extern "C" void kernel_launch(void* const* d_in, const int* in_sizes, int n_in, void* d_out, int out_size, void* d_ws, size_t ws_size, hipStream_t stream) {
    static int grid_blocks = 0;
    if (grid_blocks == 0) {
        if (n_in != 22 || in_sizes[0] != NTOK * D || out_size != NTOK * D || ws_size < WS_NEED) {
            fprintf(stderr, "kernel_launch: unexpected shapes (n_in %d, in0 %d, out %d, ws %zu, need %zu); nothing launched\n", n_in, n_in > 0 ? in_sizes[0] : -1, out_size, ws_size, (size_t)WS_NEED);
            grid_blocks = -1; return; }
        int dev = 0, cus = 0, per_cu = 0;
        hipGetDevice(&dev);
        hipDeviceGetAttribute(&cus, hipDeviceAttributeMultiprocessorCount, dev);
        if (hipFuncSetAttribute((const void*)fwd_megakernel, hipFuncAttributeMaxDynamicSharedMemorySize, LDS_BYTES) != hipSuccess) { fprintf(stderr, "kernel_launch: hipFuncSetAttribute failed\n"); grid_blocks = -1; return; }
        if (hipOccupancyMaxActiveBlocksPerMultiprocessor(&per_cu, (const void*)fwd_megakernel, NTHR, LDS_BYTES) != hipSuccess || per_cu < 1) { fprintf(stderr, "kernel_launch: occupancy query failed (%d)\n", per_cu); grid_blocks = -1; (void)hipGetLastError(); return; }
        if (per_cu > 1) per_cu = 1;
        grid_blocks = cus * per_cu;
    }
    if (grid_blocks < 0) return;
    hipMemsetAsync((char*)d_ws + OFF_CTL, 0, 65536, stream);
    Params p{};
    p.x = (const float*)d_in[0]; p.norm1_w = (const float*)d_in[1]; p.w_in = (const float*)d_in[2]; p.gla_w2_f = (const float*)d_in[3]; p.gla_b_f = (const float*)d_in[4];
    p.gla_w2_b = (const float*)d_in[5]; p.gla_b_b = (const float*)d_in[6]; p.gla_norm_w = (const float*)d_in[7]; p.conv_w = (const float*)d_in[8]; p.a_log_f = (const float*)d_in[9];
    p.dt_bias_f = (const float*)d_in[10]; p.a_log_b = (const float*)d_in[11]; p.dt_bias_b = (const float*)d_in[12]; p.gdn_norm_w = (const float*)d_in[13]; p.w_out = (const float*)d_in[14];
    p.norm2_w = (const float*)d_in[15]; p.w_group = (const float*)d_in[16]; p.w_router = (const float*)d_in[17]; p.w_gate = (const float*)d_in[18]; p.w_up = (const float*)d_in[19];
    p.w_down = (const float*)d_in[20]; p.norm_f_w = (const float*)d_in[21];
    p.out = (float*)d_out; p.ws = (unsigned char*)d_ws; p.ph_lo = 0; p.ph_hi = NPHASES;
    hipLaunchKernelGGL(fwd_megakernel, dim3(grid_blocks), dim3(NTHR), LDS_BYTES, stream, p);
    const hipError_t e = hipPeekAtLastError();
    if (e != hipSuccess) fprintf(stderr, "kernel_launch: launch failed: %s (grid %d)\n", hipGetErrorString(e), grid_blocks);
}
```
